# Optimizing an MI355X kernel written in HIP

```python
import math
import jax, jax.numpy as jnp
from jax import lax
import numpy as np

D_MODEL = 1024
BATCH = 8
SEQ = 2048
DEPTH = 1

MLA_HEADS = 8
QK_NOPE_DIM = 64
QK_ROPE_DIM = 32
QK_HEAD_DIM = QK_NOPE_DIM + QK_ROPE_DIM
V_HEAD_DIM = 64
Q_LORA_RANK = 256
KV_LORA_RANK = 128
ROPE_THETA = 10000.0
Q_BLOCK = 128
HYENA_WIDTH = 512
HYENA_GROUPS = 8
FILTER_EMB = 33
FILTER_ORDER = 64
FAST_DECAY_PCT = 0.3
SLOW_DECAY_PCT = 1.5
DECAY_TARGET = 1e-2
PEER_HEADS = 8
N_KEYS = 128
N_EXPERTS = N_KEYS * N_KEYS
PEER_KEY_DIM = 256
PEER_TOPK = 16
PEER_TOKEN_BLOCK = 128
GATE_WIDTH = 2 * D_MODEL
IN_SPLITS = (Q_LORA_RANK, KV_LORA_RANK + QK_ROPE_DIM, 3 * HYENA_WIDTH, GATE_WIDTH)
IN_COLS = sum(IN_SPLITS)
EPS = 1e-6

kernel_name = 'hybrid_mla_hyena_peer_encoder'


def rms_norm(x, g):
    xf = x.astype(jnp.float32)
    y = xf * lax.rsqrt(jnp.mean(xf * xf, axis=-1, keepdims=True) + EPS)
    return (y * g.astype(jnp.float32)).astype(x.dtype)


def rotary(x):
    S = x.shape[1]
    half = QK_ROPE_DIM // 2
    inv_freq = ROPE_THETA ** (-jnp.arange(half, dtype=jnp.float32) / half)
    ang = jnp.arange(S, dtype=jnp.float32)[:, None] * inv_freq[None, :]
    cos = jnp.cos(ang)[None, :, None, :]
    sin = jnp.sin(ang)[None, :, None, :]
    x1 = x[..., :half].astype(jnp.float32)
    x2 = x[..., half:].astype(jnp.float32)
    out = jnp.concatenate([x1 * cos - x2 * sin, x2 * cos + x1 * sin], axis=-1)
    return out.astype(x.dtype)


def block_attention(q, k, v):
    B, S, H, Dh = q.shape
    nb = S // Q_BLOCK
    scale = QK_HEAD_DIM ** -0.5
    qb = q.reshape(B, nb, Q_BLOCK, H, Dh).transpose(1, 0, 2, 3, 4)

    def one_block(qi):
        s = jnp.einsum('bqhd,bkhd->bhqk', qi, k, preferred_element_type=jnp.float32) * scale
        p = jax.nn.softmax(s, axis=-1).astype(v.dtype)
        return jnp.einsum('bhqk,bkhd->bqhd', p, v)

    o = lax.map(one_block, qb)
    return o.transpose(1, 0, 2, 3, 4).reshape(B, S, H * V_HEAD_DIM)


def mla_branch(c_q, ckv_pe, q_a_norm, w_uq, kv_a_norm, w_ukv, q_norm, k_norm):
    B, S, _ = c_q.shape
    c_q = rms_norm(c_q, q_a_norm)
    q = (c_q @ w_uq).reshape(B, S, MLA_HEADS, QK_HEAD_DIM)
    c_kv = rms_norm(ckv_pe[..., :KV_LORA_RANK], kv_a_norm)
    k_pe = ckv_pe[..., KV_LORA_RANK:]
    kv = (c_kv @ w_ukv).reshape(B, S, MLA_HEADS, QK_NOPE_DIM + V_HEAD_DIM)
    k_nope, v = kv[..., :QK_NOPE_DIM], kv[..., QK_NOPE_DIM:]
    k = jnp.concatenate([k_nope, jnp.broadcast_to(k_pe[:, :, None, :], (B, S, MLA_HEADS, QK_ROPE_DIM))], axis=-1)
    q = rms_norm(q, q_norm)
    k = rms_norm(k, k_norm)
    q = jnp.concatenate([q[..., :QK_NOPE_DIM], rotary(q[..., QK_NOPE_DIM:])], axis=-1)
    k = jnp.concatenate([k[..., :QK_NOPE_DIM], rotary(k[..., QK_NOPE_DIM:])], axis=-1)
    return block_attention(q, k, v)


def short_conv(u, w, b):
    S = u.shape[1]
    up = jnp.pad(u, ((0, 0), (1, 1), (0, 0)))
    return up[:, :S] * w[0] + up[:, 1:S + 1] * w[1] + up[:, 2:] * w[2] + b


def implicit_filters(L, w1, b1, w2, b2, w3, b3, w4, b4, freq):
    f32 = jnp.float32
    t = jnp.linspace(0.0, 1.0, L, dtype=f32)[:, None]
    bands = (FILTER_EMB - 1) // 2
    w = 2.0 * math.pi * jnp.arange(L, dtype=f32)[:, None] / L
    f = jnp.linspace(1e-4, bands - 1, bands, dtype=f32)[None, :]
    z = jnp.concatenate([t, jnp.cos(f * w), -jnp.sin(f * w)], axis=-1)
    fr = freq.astype(f32)
    h = jnp.sin(fr * (z @ w1.astype(f32) + b1.astype(f32)))
    h = jnp.sin(fr * (h @ w2.astype(f32) + b2.astype(f32)))
    h = jnp.sin(fr * (h @ w3.astype(f32) + b3.astype(f32)))
    h = h @ w4.astype(f32) + b4.astype(f32)
    min_decay = math.log(DECAY_TARGET) / SLOW_DECAY_PCT
    max_decay = math.log(DECAY_TARGET) / FAST_DECAY_PCT
    deltas = jnp.abs(jnp.linspace(min_decay, max_decay, HYENA_WIDTH, dtype=f32))
    decay = jnp.exp(-t * deltas[None, :])
    h = h.reshape(L, 2, HYENA_WIDTH) * decay[:, None, :]
    h_fwd, h_bwd = h[:, 0], h[:, 1]
    return jnp.concatenate([h_fwd, jnp.zeros((1, HYENA_WIDTH), f32), h_bwd[1:][::-1]], axis=0)


def long_conv(z, k_two, bias):
    L = z.shape[1]
    zf = jnp.fft.rfft(z.astype(jnp.float32), n=2 * L, axis=1)
    kf = jnp.fft.rfft(k_two, n=2 * L, axis=0)
    y = jnp.fft.irfft(zf * kf[None], n=2 * L, axis=1)[:, :L]
    return (y + z.astype(jnp.float32) * bias.astype(jnp.float32)).astype(z.dtype)


def hyena_branch(u, conv_w, conv_b, w1, b1, w2, b2, w3, b3, w4, b4, freq, bias):
    L = u.shape[1]
    uc = short_conv(u, conv_w, conv_b)
    x0, x1, v = jnp.split(uc, 3, axis=-1)
    k_two = implicit_filters(L, w1, b1, w2, b2, w3, b3, w4, b4, freq)
    z = long_conv(v * x1, k_two, bias)
    return x0 * z


def peer(xn, w_q, keys1, keys2, expert_u, expert_v):
    B, S, D = xn.shape
    nb = (B * S) // PEER_TOKEN_BLOCK
    xt = xn.reshape(nb, PEER_TOKEN_BLOCK, D)
    half = PEER_KEY_DIM // 2

    def one_block(xb):
        q = (xb @ w_q).reshape(PEER_TOKEN_BLOCK, PEER_HEADS, 2, half)
        s1 = jnp.einsum('thd,hkd->thk', q[:, :, 0], keys1, preferred_element_type=jnp.float32)
        s2 = jnp.einsum('thd,hkd->thk', q[:, :, 1], keys2, preferred_element_type=jnp.float32)
        v1, i1 = lax.top_k(s1, PEER_TOPK)
        v2, i2 = lax.top_k(s2, PEER_TOPK)
        cand = (v1[..., :, None] + v2[..., None, :]).reshape(PEER_TOKEN_BLOCK, PEER_HEADS, PEER_TOPK * PEER_TOPK)
        cand_idx = (i1[..., :, None] * N_KEYS + i2[..., None, :]).reshape(PEER_TOKEN_BLOCK, PEER_HEADS, PEER_TOPK * PEER_TOPK)
        top_s, pos = lax.top_k(cand, PEER_TOPK)
        idx = jnp.take_along_axis(cand_idx, pos, axis=-1)
        g = jax.nn.softmax(top_s, axis=-1)
        u = expert_u[idx]
        act = jax.nn.gelu(jnp.einsum('thkd,td->thk', u, xb), approximate=False)
        wgt = (g * act).astype(xb.dtype)
        vv = expert_v[idx]
        return jnp.einsum('thk,thkd->td', wgt, vv)

    y = lax.map(one_block, xt)
    return y.reshape(B, S, D)


def setup_inputs(seed: int = 0) -> dict:
    key = jax.random.key(seed)
    ks = jax.random.split(key, 32)
    nrm = lambda k, shape, s: jax.random.normal(k, shape, jnp.float32) * s
    gain = lambda k, n: 1.0 + 0.02 * jax.random.normal(k, (DEPTH, n), jnp.float32)
    Ld = DEPTH
    return {
        'x': nrm(ks[0], (BATCH, SEQ, D_MODEL), 1.0),
        'attn_norm': gain(ks[1], D_MODEL),
        'w_in': nrm(ks[2], (Ld, D_MODEL, IN_COLS), D_MODEL ** -0.5),
        'b_gate': nrm(ks[3], (Ld, GATE_WIDTH), 0.02),
        'q_a_norm': gain(ks[4], Q_LORA_RANK),
        'w_uq': nrm(ks[5], (Ld, Q_LORA_RANK, MLA_HEADS * QK_HEAD_DIM), Q_LORA_RANK ** -0.5),
        'kv_a_norm': gain(ks[6], KV_LORA_RANK),
        'w_ukv': nrm(ks[7], (Ld, KV_LORA_RANK, MLA_HEADS * (QK_NOPE_DIM + V_HEAD_DIM)), KV_LORA_RANK ** -0.5),
        'q_norm': gain(ks[8], QK_HEAD_DIM),
        'k_norm': gain(ks[9], QK_HEAD_DIM),
        'w_o_attn': nrm(ks[10], (Ld, MLA_HEADS * V_HEAD_DIM, D_MODEL), (MLA_HEADS * V_HEAD_DIM) ** -0.5),
        'hyena_conv_w': nrm(ks[11], (Ld, 3, 3 * HYENA_WIDTH), 3 ** -0.5),
        'hyena_conv_b': nrm(ks[12], (Ld, 3 * HYENA_WIDTH), 0.02),
        'filt_w1': nrm(ks[13], (Ld, FILTER_EMB, FILTER_ORDER), FILTER_EMB ** -0.5),
        'filt_b1': nrm(ks[14], (Ld, FILTER_ORDER), 0.1),
        'filt_w2': nrm(ks[15], (Ld, FILTER_ORDER, FILTER_ORDER), FILTER_ORDER ** -0.5),
        'filt_b2': nrm(ks[16], (Ld, FILTER_ORDER), 0.1),
        'filt_w3': nrm(ks[17], (Ld, FILTER_ORDER, FILTER_ORDER), FILTER_ORDER ** -0.5),
        'filt_b3': nrm(ks[18], (Ld, FILTER_ORDER), 0.1),
        'filt_w4': nrm(ks[19], (Ld, FILTER_ORDER, 2 * HYENA_WIDTH), 0.125 * FILTER_ORDER ** -0.5),
        'filt_b4': nrm(ks[20], (Ld, 2 * HYENA_WIDTH), 0.01),
        'filt_freq': gain(ks[21], FILTER_ORDER),
        'hyena_bias': nrm(ks[22], (Ld, HYENA_WIDTH), 1.0),
        'w_o_hyena': nrm(ks[23], (Ld, HYENA_WIDTH, D_MODEL), HYENA_WIDTH ** -0.5),
        'w_out': nrm(ks[24], (Ld, D_MODEL, D_MODEL), D_MODEL ** -0.5),
        'ffn_norm': gain(ks[25], D_MODEL),
        'peer_w_q': nrm(ks[26], (Ld, D_MODEL, PEER_HEADS * PEER_KEY_DIM), D_MODEL ** -0.5),
        'peer_keys1': nrm(ks[27], (Ld, PEER_HEADS, N_KEYS, PEER_KEY_DIM // 2), (PEER_KEY_DIM // 2) ** -0.5),
        'peer_keys2': nrm(ks[28], (Ld, PEER_HEADS, N_KEYS, PEER_KEY_DIM // 2), (PEER_KEY_DIM // 2) ** -0.5),
        'expert_u': nrm(ks[29], (Ld, N_EXPERTS, D_MODEL), D_MODEL ** -0.5),
        'expert_v': nrm(ks[30], (Ld, N_EXPERTS, D_MODEL), (PEER_HEADS * PEER_TOPK) ** -0.5),
    }


def reference(x, attn_norm, w_in, b_gate, q_a_norm, w_uq, kv_a_norm, w_ukv, q_norm, k_norm, w_o_attn,
              hyena_conv_w, hyena_conv_b, filt_w1, filt_b1, filt_w2, filt_b2, filt_w3, filt_b3, filt_w4, filt_b4,
              filt_freq, hyena_bias, w_o_hyena, w_out, ffn_norm, peer_w_q, peer_keys1, peer_keys2, expert_u, expert_v):
    offs = list(np.cumsum(IN_SPLITS)[:-1])
    h = x
    for layer in range(DEPTH):
        xn = rms_norm(h, attn_norm[layer])
        proj = xn @ w_in[layer]
        c_q, ckv_pe, u_hy, gate_logits = jnp.split(proj, offs, axis=-1)
        gates = jax.nn.sigmoid((gate_logits + b_gate[layer]).astype(jnp.float32))
        g_attn, g_hy = gates[..., :D_MODEL], gates[..., D_MODEL:]
        a = mla_branch(c_q, ckv_pe, q_a_norm[layer], w_uq[layer], kv_a_norm[layer], w_ukv[layer],
                       q_norm[layer], k_norm[layer]) @ w_o_attn[layer]
        y_hy = hyena_branch(u_hy, hyena_conv_w[layer], hyena_conv_b[layer], filt_w1[layer], filt_b1[layer],
                            filt_w2[layer], filt_b2[layer], filt_w3[layer], filt_b3[layer], filt_w4[layer],
                            filt_b4[layer], filt_freq[layer], hyena_bias[layer]) @ w_o_hyena[layer]
        merged = (g_attn * a + g_hy * y_hy).astype(h.dtype)
        h = h + merged @ w_out[layer]
        hn = rms_norm(h, ffn_norm[layer])
        h = h + peer(hn, peer_w_q[layer], peer_keys1[layer], peer_keys2[layer], expert_u[layer], expert_v[layer])
    return h
```

```cpp
#include <hip/hip_runtime.h>
#include <hip/hip_cooperative_groups.h>
#include <cstdio>
#include <cstdint>
namespace cg = cooperative_groups;

#ifndef MULTI_LAUNCH
#define MULTI_LAUNCH 0
#endif

typedef unsigned short u16;
typedef __attribute__((ext_vector_type(8))) short bf16x8;
typedef __attribute__((ext_vector_type(4))) float f32x4;
typedef __attribute__((ext_vector_type(16))) float f32x16;
typedef __attribute__((ext_vector_type(4))) unsigned U4;
typedef __attribute__((ext_vector_type(2))) unsigned U2;
typedef __attribute__((ext_vector_type(4))) float F4;

constexpr int T_TOK = 16384;
constexpr int SEQ = 2048;
constexpr float EPS = 1e-6f;
constexpr int SMEM_BYTES = 72192;
constexpr int OFF_SB = 34816;
constexpr int OFF_RS = 71680;
constexpr int ZS = 2248;

struct Params {
  const float *x, *attn_norm, *w_in, *b_gate, *q_a_norm, *w_uq, *kv_a_norm, *w_ukv, *q_norm, *k_norm, *w_o_attn,
      *conv_w, *conv_b, *fw1, *fb1, *fw2, *fb2, *fw3, *fb3, *fw4, *fb4, *ffreq, *hbias, *w_o_hyena, *w_out, *ffn_norm,
      *peer_wq, *keys1, *keys2, *eu, *ev;
  float* out;
  u16 *xb, *w_inT, *w_uqT, *w_ukvT, *w_oaT, *w_ohT, *w_outT, *wqb, *keysb, *wcT, *eub, *evb;
  u16 *cq, *ckv, *uT, *gates, *Q, *K, *Vt, *attn_out, *yhT, *merged, *hb;
  float *h3, *rstd1, *ssq2, *sel_g;
  int* sel_idx;
  unsigned* bar;
  unsigned char *eu8, *ev8;
  float *eus, *evs;
  u16* filt;
  float* tk;
  int use_cg; int pad_;
};

typedef __bf16 bf16x2_t __attribute__((ext_vector_type(2)));
typedef float f32x2_t __attribute__((ext_vector_type(2)));
__device__ __forceinline__ unsigned pack2(float a, float b) {
  const f32x2_t v = {a, b};
  return __builtin_bit_cast(unsigned, __builtin_convertvector(v, bf16x2_t));
}
__device__ __forceinline__ u16 f2bf(float f) { return (u16)(pack2(f, 0.f) & 0xffffu); }
__device__ __forceinline__ int tidx() { int t = threadIdx.x; asm volatile("" : "+v"(t)); return t; }
__device__ __forceinline__ int lbid() { int b = blockIdx.x; asm volatile("" : "+s"(b)); return b; }
__device__ __forceinline__ float bf2f(u16 h) { return __uint_as_float(((unsigned)h) << 16); }
__device__ __forceinline__ float bflo(unsigned w) { return __uint_as_float(w << 16); }
__device__ __forceinline__ float bfhi(unsigned w) { return __uint_as_float(w & 0xffff0000u); }
__device__ __forceinline__ float wave_sum(float v) {
#pragma unroll
  for (int o = 32; o > 0; o >>= 1) v += __shfl_xor(v, o);
  return v;
}
__device__ __forceinline__ float sum16(float v) {
  v += __shfl_xor(v, 1); v += __shfl_xor(v, 2); v += __shfl_xor(v, 4); v += __shfl_xor(v, 8);
  return v;
}


#define XB_TMO      128
#define XB_XCNT(j)  (256  + 64 * (j))
#define XB_XSUB(j)  (1280 + 64 * (j))
#define XB_XGEN(j)  (2304 + 64 * (j))
#define XB_TOP      3328
#define XB_TOPGEN   3392
#define XCD_BAR_WORDS 3456
#define XB_SPIN_CAP (1u << 22)
#define LAS __attribute__((address_space(3)))
__device__ __forceinline__ unsigned xb_ld(unsigned* p)              { return __hip_atomic_load(p, __ATOMIC_RELAXED, __HIP_MEMORY_SCOPE_AGENT); }
__device__ __forceinline__ unsigned xb_add(unsigned* p, unsigned v) { return __hip_atomic_fetch_add(p, v, __ATOMIC_RELAXED, __HIP_MEMORY_SCOPE_AGENT); }
__device__ __forceinline__ unsigned xb_xcc_id() { return (unsigned)__builtin_amdgcn_s_getreg((3 << 11) | 20) & 0xFu; }
#define XB_SPIN(cond, bar) do { unsigned _sp = 0; while (cond) { __builtin_amdgcn_s_sleep(1); \
    if ((++_sp & 255u) == 0u) { if (xb_ld(&(bar)[XB_TMO])) break; if (_sp > XB_SPIN_CAP) { atomicAdd(&(bar)[XB_TMO], 1u); break; } } } } while (0)
struct XcdBarrier { unsigned* bar; unsigned x; volatile LAS unsigned* st; };
__device__ __forceinline__ XcdBarrier xcd_barrier_post(unsigned* bar, volatile LAS unsigned* st) {
  XcdBarrier b; b.bar = bar; b.x = xb_xcc_id(); b.st = st;
  if (threadIdx.x == 0) (void)xb_add(&bar[XB_XCNT(b.x)], 1u);
  return b;
}
__device__ __forceinline__ void xcd_barrier_complete(unsigned* bar, unsigned x, unsigned& nloc, unsigned& nx) {
  const unsigned G = gridDim.x * gridDim.y * gridDim.z;
  unsigned sum, cnt, mine, sp = 0u;
  for (;;) {
    sum = 0u; cnt = 0u; mine = 0u;
#pragma unroll
    for (unsigned j = 0; j < 16; ++j) { const unsigned c = xb_ld(&bar[XB_XCNT(j)]); sum += c; cnt += (c > 0u) ? 1u : 0u; mine = (j == x) ? c : mine; }
    if (sum == G) break;
    __builtin_amdgcn_s_sleep(1);
    if ((++sp & 255u) == 0u) { if (xb_ld(&bar[XB_TMO])) break; if (sp > XB_SPIN_CAP) { atomicAdd(&bar[XB_TMO], 1u); break; } }
  }
  nloc = mine > 0u ? mine : 1u; nx = cnt > 0u ? cnt : 1u;
}
__device__ __forceinline__ void xcd_barrier(const XcdBarrier& b) {
  asm volatile("s_waitcnt vmcnt(0)" ::: "memory");
  __syncthreads();
  if (threadIdx.x == 0) {
    unsigned* bar = b.bar;
    __builtin_amdgcn_s_waitcnt(0);
    unsigned nloc = b.st[0], nx = b.st[1];
    if (nloc == 0u) { xcd_barrier_complete(bar, b.x, nloc, nx); b.st[0] = nloc; b.st[1] = nx; }
    const unsigned old = xb_add(&bar[XB_XSUB(b.x)], 1u);
    const unsigned gen = old / nloc;
    if (old + 1u == (gen + 1u) * nloc) {
      __builtin_amdgcn_fence(__ATOMIC_RELEASE, "agent");
      asm volatile("s_waitcnt vmcnt(0)" ::: "memory");
      const unsigned og = xb_add(&bar[XB_TOP], 1u);
      const unsigned tg = og / nx;
      if (og + 1u == (tg + 1u) * nx) xb_add(&bar[XB_TOPGEN], 1u);
      else XB_SPIN(xb_ld(&bar[XB_TOPGEN]) == tg, bar);
      __builtin_amdgcn_fence(__ATOMIC_ACQUIRE, "agent");
      xb_add(&bar[XB_XGEN(b.x)], 1u);
      asm volatile("s_waitcnt vmcnt(0)" ::: "memory");
    } else {
      XB_SPIN(xb_ld(&bar[XB_XGEN(b.x)]) == gen, bar);
      __builtin_amdgcn_fence(__ATOMIC_ACQUIRE, "agent");
      asm volatile("s_waitcnt vmcnt(0)" ::: "memory");
    }
  }
  __syncthreads();
}

template <int BM, int BN, int WM, int WN, bool ATRANS, int BK>
__device__ __forceinline__ void gemm_main(const u16* A, int lda, const u16* Bt, int ldb, int K, int m0, int n0,
                                          u16* sA, u16* sB, f32x4 (&acc)[BM / WM / 16][BN / WN / 16]) {
  constexpr int MT = BM / WM / 16, NTL = BN / WN / 16;
  constexpr int CPR = BK / 8;
  constexpr int LDK = BK + 8;
  constexpr int ACH = BM * CPR / 256, BCH = BN * CPR / 256;
  const int tid = tidx(), lane = tid & 63, wave = __builtin_amdgcn_readfirstlane(tid >> 6);
  const int wm = wave / WN, wn = wave % WN;
  const int c = lane & 15, g = lane >> 4;
  U4 ra[ACH], rb[BCH];
  const int nk = K / BK;
  const int krot = (int)((unsigned)(blockIdx.x >> 3) % (unsigned)nk);
#pragma unroll
  for (int i = 0; i < ACH; ++i) {
    int ch = tid + i * 256;
    if (!ATRANS) { int row = ch / CPR, kc = ch % CPR; ra[i] = *(const U4*)(A + (size_t)(m0 + row) * lda + krot * BK + kc * 8); }
    else { int k = ch / (BM / 8), mc = ch % (BM / 8); ra[i] = *(const U4*)(A + (size_t)(krot * BK + k) * lda + m0 + mc * 8); }
  }
#pragma unroll
  for (int i = 0; i < BCH; ++i) {
    int ch = tid + i * 256; int row = ch / CPR, kc = ch % CPR;
    rb[i] = *(const U4*)(Bt + (size_t)(n0 + row) * ldb + krot * BK + kc * 8);
  }
  for (int kt = 0; kt < nk; ++kt) {
    __syncthreads();
#pragma unroll
    for (int i = 0; i < ACH; ++i) {
      int ch = tid + i * 256;
      if (!ATRANS) { int row = ch / CPR, kc = ch % CPR; *(U4*)(sA + row * LDK + kc * 8) = ra[i]; }
      else {
        int k = ch / (BM / 8), mc = ch % (BM / 8);
        u16* d = sA + (mc * 8) * LDK + k;
        d[0 * LDK] = (u16)(ra[i].x & 0xffff); d[1 * LDK] = (u16)(ra[i].x >> 16);
        d[2 * LDK] = (u16)(ra[i].y & 0xffff); d[3 * LDK] = (u16)(ra[i].y >> 16);
        d[4 * LDK] = (u16)(ra[i].z & 0xffff); d[5 * LDK] = (u16)(ra[i].z >> 16);
        d[6 * LDK] = (u16)(ra[i].w & 0xffff); d[7 * LDK] = (u16)(ra[i].w >> 16);
      }
    }
#pragma unroll
    for (int i = 0; i < BCH; ++i) {
      int ch = tid + i * 256; int row = ch / CPR, kc = ch % CPR;
      *(U4*)(sB + row * LDK + kc * 8) = rb[i];
    }
    __syncthreads();
    if (kt + 1 < nk) {
      int kn = kt + 1 + krot; if (kn >= nk) kn -= nk;
      const int k0 = kn * BK;
#pragma unroll
      for (int i = 0; i < ACH; ++i) {
        int ch = tid + i * 256;
        if (!ATRANS) { int row = ch / CPR, kc = ch % CPR; ra[i] = *(const U4*)(A + (size_t)(m0 + row) * lda + k0 + kc * 8); }
        else { int k = ch / (BM / 8), mc = ch % (BM / 8); ra[i] = *(const U4*)(A + (size_t)(k0 + k) * lda + m0 + mc * 8); }
      }
#pragma unroll
      for (int i = 0; i < BCH; ++i) {
        int ch = tid + i * 256; int row = ch / CPR, kc = ch % CPR;
        rb[i] = *(const U4*)(Bt + (size_t)(n0 + row) * ldb + k0 + kc * 8);
      }
    }
#pragma unroll
    for (int ks = 0; ks < BK / 32; ++ks) {
      bf16x8 af[MT], bfr[NTL];
#pragma unroll
      for (int mt = 0; mt < MT; ++mt) af[mt] = *(const bf16x8*)(sA + (wm * (BM / WM) + mt * 16 + c) * LDK + ks * 32 + g * 8);
#pragma unroll
      for (int nt = 0; nt < NTL; ++nt) bfr[nt] = *(const bf16x8*)(sB + (wn * (BN / WN) + nt * 16 + c) * LDK + ks * 32 + g * 8);
#pragma unroll
      for (int mt = 0; mt < MT; ++mt)
#pragma unroll
        for (int nt = 0; nt < NTL; ++nt)
          acc[mt][nt] = __builtin_amdgcn_mfma_f32_16x16x32_bf16(af[mt], bfr[nt], acc[mt][nt], 0, 0, 0);
    }
  }
}


template <int BM, int BN, int WM, int WN, bool SWAP = false>
__device__ __forceinline__ void gemm_glds(const u16* A, int lda, const u16* Bt, int ldb, int K, int m0, int n0,
                                          unsigned char* smem, f32x4 (&acc)[BM / WM / 16][BN / WN / 16]) {
  constexpr int MT = BM / WM / 16, NTL = BN / WN / 16;
  constexpr int TA = BM * 128, TB = BN * 128, STAGE = TA + TB;
  constexpr int GA = BM / 32, GB = BN / 32;
  const int tid = tidx(), lane = tid & 63, wave = __builtin_amdgcn_readfirstlane(tid >> 6);
  const int wm = wave / WN, wn = wave % WN;
  const int c = lane & 15, g = lane >> 4;
  const int rg = lane >> 3, kcs = ((lane & 7) ^ rg) * 8;
  const int nk = K / 64;
  const int krot = (int)((unsigned)(blockIdx.x >> 3) % (unsigned)nk);
  const u16* asrc = A + (size_t)(m0 + wave * 8 + rg) * lda + kcs;
  const u16* bsrc = Bt + (size_t)(n0 + wave * 8 + rg) * ldb + kcs;
#define GLDS_STAGE(buf, kt)                                                                                          \
  {                                                                                                                  \
    unsigned char* sa_ = smem + (buf) * STAGE + wave * 1024;                                                         \
    _Pragma("unroll") for (int i_ = 0; i_ < GA; ++i_)                                                                \
      __builtin_amdgcn_global_load_lds((const unsigned*)(asrc + (size_t)(i_ * 32) * lda + (kt) * 64),                \
                                       (unsigned*)(sa_ + i_ * 4096), 16, 0, 0);                                      \
    _Pragma("unroll") for (int i_ = 0; i_ < GB; ++i_)                                                                \
      __builtin_amdgcn_global_load_lds((const unsigned*)(bsrc + (size_t)(i_ * 32) * ldb + (kt) * 64),                \
                                       (unsigned*)(sa_ + TA + i_ * 4096), 16, 0, 0);                                 \
  }
  __syncthreads();
  GLDS_STAGE(0, krot)
  asm volatile("s_waitcnt vmcnt(0)" ::: "memory");
  __syncthreads();
#pragma unroll 4
  for (int kt = 0; kt < nk; ++kt) {
    const int cur = kt & 1;
    int kn = kt + 1 + krot; if (kn >= nk) kn -= nk;
    if (kt + 1 < nk) GLDS_STAGE(cur ^ 1, kn)
    const unsigned char* pa = smem + cur * STAGE;
    const unsigned char* pb = pa + TA;
#pragma unroll
    for (int ks = 0; ks < 2; ++ks) {
      bf16x8 af[MT], bfr[NTL];
      const int cho = (((ks * 4 + g) ^ (c & 7)) * 16);
#pragma unroll
      for (int mt = 0; mt < MT; ++mt) af[mt] = *(const bf16x8*)(pa + (wm * (BM / WM) + mt * 16 + c) * 128 + cho);
#pragma unroll
      for (int nt = 0; nt < NTL; ++nt) bfr[nt] = *(const bf16x8*)(pb + (wn * (BN / WN) + nt * 16 + c) * 128 + cho);
#pragma unroll
      for (int mt = 0; mt < MT; ++mt)
#pragma unroll
        for (int nt = 0; nt < NTL; ++nt)
          acc[mt][nt] = SWAP ? __builtin_amdgcn_mfma_f32_16x16x32_bf16(bfr[nt], af[mt], acc[mt][nt], 0, 0, 0)
                             : __builtin_amdgcn_mfma_f32_16x16x32_bf16(af[mt], bfr[nt], acc[mt][nt], 0, 0, 0);
    }
    asm volatile("s_waitcnt vmcnt(0)" ::: "memory");
    __syncthreads();
  }
#undef GLDS_STAGE
}

template <bool SWAP>
__device__ __forceinline__ void gemm_glds_at(const u16* At, int ldat, const u16* Bt, int ldb, int K, int m0, int n0,
                                             unsigned char* smem, f32x4 (&acc)[4][4]) {
  constexpr int IA = 1040, TA = 16 * IA, TB = 128 * 128, STAGE = TA + TB;
  const int tid = tidx(), lane = tid & 63, wave = __builtin_amdgcn_readfirstlane(tid >> 6);
  const int wm = wave >> 1, wn = wave & 1;
  const int c = lane & 15, g = lane >> 4;
  const int rg = lane >> 3, kcs = ((lane & 7) ^ rg) * 8;
  const int nk = K / 64;
  const int krot = (int)((unsigned)(blockIdx.x >> 3) % (unsigned)nk);
  const u16* asrc = At + (size_t)(wave * 4 + (lane >> 4)) * ldat + m0 + (lane & 15) * 8;
  const u16* bsrc = Bt + (size_t)(n0 + wave * 8 + rg) * ldb + kcs;
#define GLDS_STAGE_AT(buf, kt)                                                                                       \
  {                                                                                                                  \
    unsigned char* sa_ = smem + (buf) * STAGE;                                                                       \
    _Pragma("unroll") for (int i_ = 0; i_ < 4; ++i_)                                                                 \
      __builtin_amdgcn_global_load_lds((const unsigned*)(asrc + (size_t)((kt) * 64 + i_ * 16) * ldat),               \
                                       (unsigned*)(sa_ + (wave + i_ * 4) * IA), 16, 0, 0);                           \
    _Pragma("unroll") for (int i_ = 0; i_ < 4; ++i_)                                                                 \
      __builtin_amdgcn_global_load_lds((const unsigned*)(bsrc + (size_t)(i_ * 32) * ldb + (kt) * 64),                \
                                       (unsigned*)(sa_ + TA + wave * 1024 + i_ * 4096), 16, 0, 0);                   \
  }
  __syncthreads();
  GLDS_STAGE_AT(0, krot)
  asm volatile("s_waitcnt vmcnt(0)" ::: "memory");
  __syncthreads();
#pragma unroll 2
  for (int kt = 0; kt < nk; ++kt) {
    const int cur = kt & 1;
    int kn = kt + 1 + krot; if (kn >= nk) kn -= nk;
    if (kt + 1 < nk) GLDS_STAGE_AT(cur ^ 1, kn)
    const unsigned char* pa = smem + cur * STAGE;
    const unsigned char* pb = pa + TA;
#pragma unroll
    for (int ks = 0; ks < 2; ++ks) {
      bf16x8 af[4], bfr[4];
      const int cho = (((ks * 4 + g) ^ (c & 7)) * 16);
#pragma unroll
      for (int mt = 0; mt < 4; ++mt) {
        const unsigned char* q = pa + (ks * 8 + 2 * g) * IA + (wm * 64 + mt * 16 + c) * 2;
        const unsigned e0 = *(const u16*)(q), e1 = *(const u16*)(q + 256), e2 = *(const u16*)(q + 512), e3 = *(const u16*)(q + 768);
        const unsigned e4 = *(const u16*)(q + IA), e5 = *(const u16*)(q + IA + 256), e6 = *(const u16*)(q + IA + 512), e7 = *(const u16*)(q + IA + 768);
        U4 w = {e0 | (e1 << 16), e2 | (e3 << 16), e4 | (e5 << 16), e6 | (e7 << 16)};
        af[mt] = __builtin_bit_cast(bf16x8, w);
      }
#pragma unroll
      for (int nt = 0; nt < 4; ++nt) bfr[nt] = *(const bf16x8*)(pb + (wn * 64 + nt * 16 + c) * 128 + cho);
#pragma unroll
      for (int mt = 0; mt < 4; ++mt)
#pragma unroll
        for (int nt = 0; nt < 4; ++nt)
          acc[mt][nt] = SWAP ? __builtin_amdgcn_mfma_f32_16x16x32_bf16(bfr[nt], af[mt], acc[mt][nt], 0, 0, 0)
                             : __builtin_amdgcn_mfma_f32_16x16x32_bf16(af[mt], bfr[nt], acc[mt][nt], 0, 0, 0);
    }
    asm volatile("s_waitcnt vmcnt(0)" ::: "memory");
    __syncthreads();
  }
#undef GLDS_STAGE_AT
}

__device__ __forceinline__ void ph_x_prep(const Params& p, int bid, int nb) {
  const int lane = tidx() & 63, wave = __builtin_amdgcn_readfirstlane(tidx() >> 6);
  for (int r = (bid * 4 + wave) * 2; r < T_TOK; r += nb * 8) {
    const F4* xr = (const F4*)(p.x + (size_t)r * 1024);
    F4 v[8]; float ss0 = 0.f, ss1 = 0.f;
#pragma unroll
    for (int i = 0; i < 8; ++i) v[i] = xr[lane + 64 * i];
#pragma unroll
    for (int i = 0; i < 4; ++i) {
      ss0 += v[i].x * v[i].x + v[i].y * v[i].y + v[i].z * v[i].z + v[i].w * v[i].w;
      ss1 += v[4 + i].x * v[4 + i].x + v[4 + i].y * v[4 + i].y + v[4 + i].z * v[4 + i].z + v[4 + i].w * v[4 + i].w;
    }
    ss0 = wave_sum(ss0); ss1 = wave_sum(ss1);
    if (lane == 0) { p.rstd1[r] = rsqrtf(ss0 * (1.f / 1024.f) + EPS); p.rstd1[r + 1] = rsqrtf(ss1 * (1.f / 1024.f) + EPS); }
#pragma unroll
    for (int i = 0; i < 8; ++i) {
      const F4 g4 = ((const F4*)p.attn_norm)[lane + 64 * (i & 3)];
      U2 o; o.x = pack2(v[i].x * g4.x, v[i].y * g4.y); o.y = pack2(v[i].z * g4.z, v[i].w * g4.w);
      ((U2*)(p.xb + (size_t)r * 1024))[lane + 64 * i] = o;
    }
  }
}

__device__ __forceinline__ void ph_transpose(const float* W, int K, int N, int Npad, u16* Wt, const float* ks, float* tile, int bid, int nb) {
  const int ntk = K / 64, ntn = Npad / 64;
  for (int it = bid; it < ntk * ntn; it += nb) {
    const int kt = it % ntk, nt = it / ntk; const int k0 = kt * 64, n0 = nt * 64;
    __syncthreads();
    for (int e = tidx(); e < 4096; e += 256) {
      int i = e >> 6, j = e & 63; int n = n0 + j;
      float v = (n < N) ? W[(size_t)(k0 + i) * N + n] : 0.f;
      if (ks) v *= ks[k0 + i];
      tile[i * 65 + j] = v;
    }
    __syncthreads();
    for (int e = tidx(); e < 4096; e += 256) {
      int j = e >> 6, i = e & 63;
      Wt[(size_t)(n0 + j) * K + k0 + i] = f2bf(tile[i * 65 + j]);
    }
  }
}

__device__ __forceinline__ void ph_convert(const float* src, u16* dst, size_t n4, int bid, int nb) {
  for (size_t i = (size_t)bid * 256 + tidx(); i < n4; i += (size_t)nb * 256) {
    F4 v = ((const F4*)src)[i];
    U2 o; o.x = pack2(v.x, v.y); o.y = pack2(v.z, v.w);
    ((U2*)dst)[i] = o;
  }
}

__device__ __forceinline__ void ph_filter_trunk(const Params& p, float* sm, int bid, int nb) {
  const int sub = __builtin_amdgcn_readfirstlane(tidx() >> 6), o = tidx() & 63;
  float* bufA = sm + sub * 128; float* bufB = bufA + 64;
  const float fr = p.ffreq[o];
  for (int it = bid; it < 512; it += nb) {
    const int t = it * 4 + sub;
    __syncthreads();
    if (o < 33) {
      float zv;
      if (o == 0) zv = (float)t / 2047.f;
      else {
        int i = (o - 1) & 15;
        float f = 1e-4f + (float)i * ((15.f - 1e-4f) / 15.f);
        float w = 6.283185307179586f * (float)t / 2048.f;
        float a = f * w;
        zv = (o <= 16) ? cosf(a) : -sinf(a);
      }
      bufA[o] = zv;
    }
    __syncthreads();
    float s = p.fb1[o];
#pragma unroll 11
    for (int k = 0; k < 33; ++k) s += bufA[k] * p.fw1[k * 64 + o];
    bufB[o] = sinf(fr * s);
    __syncthreads();
    s = p.fb2[o];
#pragma unroll 16
    for (int k = 0; k < 64; ++k) s += bufB[k] * p.fw2[k * 64 + o];
    bufA[o] = sinf(fr * s);
    __syncthreads();
    s = p.fb3[o];
#pragma unroll 16
    for (int k = 0; k < 64; ++k) s += bufA[k] * p.fw3[k * 64 + o];
    p.h3[t * 64 + o] = sinf(fr * s);
  }
}

__device__ __forceinline__ void phase0(const Params& p, unsigned char* smem, int bid, int nb) {
  float* tile = (float*)smem;
  ph_x_prep(p, bid, nb);
  ph_transpose(p.w_in, 1024, 4000, 4096, p.w_inT, nullptr, tile, bid, nb);
  ph_transpose(p.w_uq, 256, 768, 768, p.w_uqT, p.q_a_norm, tile, (bid + 64) % nb, nb);
  ph_transpose(p.w_ukv, 128, 1024, 1024, p.w_ukvT, p.kv_a_norm, tile, (bid + 128) % nb, nb);
  ph_transpose(p.w_o_attn, 512, 1024, 1024, p.w_oaT, nullptr, tile, (bid + 160) % nb, nb);
  ph_transpose(p.w_o_hyena, 512, 1024, 1024, p.w_ohT, nullptr, tile, (bid + 32) % nb, nb);
  ph_transpose(p.w_out, 1024, 1024, 1024, p.w_outT, nullptr, tile, (bid + 96) % nb, nb);
  ph_convert(p.peer_wq, p.wqb, (size_t)1024 * 2048 / 4, bid, nb);
  ph_convert(p.keys1, p.keysb, (size_t)8 * 128 * 128 / 4, bid, nb);
  ph_convert(p.keys2, p.keysb + 8 * 128 * 128, (size_t)8 * 128 * 128 / 4, bid, nb);
  __syncthreads();
  ph_filter_trunk(p, tile, nb - 1 - bid, nb);
}

__device__ __forceinline__ void filter_item(const Params& p, unsigned char* smem, int j) {
  const int tid = tidx();
  const int cp = (j & 3) * 256 + tid, t0 = (j >> 2) * 8;
  const int c = cp & 511;
  float* hl = (float*)smem;
  __syncthreads();
  {
    const float2 v = *(const float2*)(p.h3 + (size_t)t0 * 64 + tid * 2);
    hl[tid * 2] = v.x; hl[tid * 2 + 1] = v.y;
  }
  float w[64];
#pragma unroll
  for (int k = 0; k < 64; ++k) w[k] = p.fw4[k * 1024 + cp];
  const float dmin = -3.0701134573253943f, dmax = -15.350567286626972f;
  const float delta = fabsf(dmin + (float)c * ((dmax - dmin) / 511.f));
  const float b4 = p.fb4[cp];
  __syncthreads();
  float o[8];
#pragma unroll
  for (int i = 0; i < 8; ++i) {
    const int t = t0 + i;
    float sacc = 0.f;
#pragma unroll
    for (int k4 = 0; k4 < 16; ++k4) { const F4 hv = *(const F4*)(hl + i * 64 + k4 * 4); sacc += hv.x * w[k4 * 4] + hv.y * w[k4 * 4 + 1] + hv.z * w[k4 * 4 + 2] + hv.w * w[k4 * 4 + 3]; }
    float v = (sacc + b4) * expf(-((float)t / 2047.f) * delta);
    if (t == 0 && cp < 512) v += p.hbias[c];
    o[i] = v;
  }
  U4 ov; ov.x = pack2(o[0], o[1]); ov.y = pack2(o[2], o[3]); ov.z = pack2(o[4], o[5]); ov.w = pack2(o[6], o[7]);
  *(U4*)(p.filt + (size_t)cp * 2048 + t0) = ov;
}

__device__ __forceinline__ void qkv_items(const Params& p, unsigned char* smem, int bid, int nb);
template <int MODE>
__device__ __forceinline__ void phase1(const Params& p, unsigned char* smem, int bid, int nb) {
  const int lane = tidx() & 63, wave = __builtin_amdgcn_readfirstlane(tidx() >> 6);
  const int wm = wave >> 1, wn = wave & 1, c = lane & 15, g = lane >> 4;
  const int NTILES = (MODE == 0) ? 512 : 3584;
  const int NITEMS = (MODE == 0) ? NTILES : NTILES + 128 + 1024;
  if (MODE == 1 && bid >= (nb >> 1)) qkv_items(p, smem, bid, nb);
  for (int it = bid; it < NITEMS; it += nb) {
    if (it >= NTILES + 128) { filter_item(p, smem, it - NTILES - 128); continue; }
    f32x4 acc[4][4];
#pragma unroll
    for (int i = 0; i < 4; ++i)
#pragma unroll
      for (int j = 0; j < 4; ++j) acc[i][j] = f32x4{0.f, 0.f, 0.f, 0.f};
    if (it < NTILES) {
      const int rr_ = it >> 9, xx_ = it & 7, li_ = (it & 511) >> 3;
      const int ntile = ((MODE == 0) ? 0 : 4 + 4 * rr_) + (li_ >> 4);
      const int m0 = (16 * xx_ + (li_ & 15)) * 128, n0 = ntile * 128;
      if (ntile < 3 || ntile >= 16) {
        gemm_glds<128, 128, 2, 2, true>(p.xb, 1024, p.w_inT, 1024, 1024, m0, n0, smem, acc);
#pragma unroll
        for (int mt = 0; mt < 4; ++mt) {
          const int t = m0 + wm * 64 + mt * 16 + c;
          const float rs = p.rstd1[t];
#pragma unroll
          for (int nt = 0; nt < 4; ++nt) {
            const int n = n0 + wn * 64 + nt * 16 + g * 4;
            float v[4];
#pragma unroll
            for (int r = 0; r < 4; ++r) v[r] = acc[mt][nt][r] * rs;
            if (ntile < 2) {
              U2 o; o.x = pack2(v[0], v[1]); o.y = pack2(v[2], v[3]);
              *(U2*)(p.cq + (size_t)t * 256 + n) = o;
            } else if (ntile == 2) {
              U2 o; o.x = pack2(v[0], v[1]); o.y = pack2(v[2], v[3]);
              *(U2*)(p.ckv + (size_t)t * 160 + (n - 256)) = o;
            } else if (n < 4000) {
              const F4 bg = *(const F4*)(p.b_gate + (n - 1952));
              const float s0 = 1.f / (1.f + __expf(-(v[0] + bg.x))), s1 = 1.f / (1.f + __expf(-(v[1] + bg.y)));
              const float s2 = 1.f / (1.f + __expf(-(v[2] + bg.z))), s3 = 1.f / (1.f + __expf(-(v[3] + bg.w)));
              U2 o; o.x = pack2(s0, s1); o.y = pack2(s2, s3);
              *(U2*)(p.gates + (size_t)t * 2048 + (n - 1952)) = o;
            }
          }
        }
        continue;
      }
      gemm_glds<128, 128, 2, 2>(p.xb, 1024, p.w_inT, 1024, 1024, m0, n0, smem, acc);
#pragma unroll
      for (int mt = 0; mt < 4; ++mt) {
        const int t0 = m0 + wm * 64 + mt * 16 + g * 4;
        float rs[4];
#pragma unroll
        for (int r = 0; r < 4; ++r) rs[r] = p.rstd1[t0 + r];
#pragma unroll
        for (int nt = 0; nt < 4; ++nt) {
          const int nb0 = n0 + wn * 64 + nt * 16;
          const int n = nb0 + c;
          float v[4];
#pragma unroll
          for (int r = 0; r < 4; ++r) v[r] = acc[mt][nt][r] * rs[r];
          if (nb0 < 256) {
#pragma unroll
            for (int r = 0; r < 4; ++r) p.cq[(size_t)(t0 + r) * 256 + n] = f2bf(v[r]);
          } else if (nb0 < 416) {
#pragma unroll
            for (int r = 0; r < 4; ++r) p.ckv[(size_t)(t0 + r) * 160 + (n - 256)] = f2bf(v[r]);
          } else if (nb0 < 1952) {
            U2 o; o.x = pack2(v[0], v[1]); o.y = pack2(v[2], v[3]);
            *(U2*)(p.uT + (size_t)(n - 416) * T_TOK + t0) = o;
          } else if (nb0 < 4000) {
            const float bg = p.b_gate[n - 1952];
#pragma unroll
            for (int r = 0; r < 4; ++r) {
              float s = 1.f / (1.f + __expf(-(v[r] + bg)));
              p.gates[(size_t)(t0 + r) * 2048 + (n - 1952)] = f2bf(s);
            }
          }
        }
      }
    } else {
      const int j = it - NTILES; const int hs = j >> 3, kt = j & 7; const int h = hs >> 1, side = hs & 1;
      const u16* A = p.keysb + (size_t)((side * 8 + h) * 128) * 128;
      const u16* Bt = p.wqb + h * 256 + side * 128;
      gemm_glds<128, 128, 2, 2>(A, 128, Bt, 2048, 128, 0, kt * 128, smem, acc);
#pragma unroll
      for (int mt = 0; mt < 4; ++mt)
#pragma unroll
        for (int nt = 0; nt < 4; ++nt)
#pragma unroll
          for (int r = 0; r < 4; ++r) {
            int key = wm * 64 + mt * 16 + g * 4 + r; int k = kt * 128 + wn * 64 + nt * 16 + c;
            p.wcT[(size_t)(h * 256 + side * 128 + key) * 1024 + k] = f2bf(acc[mt][nt][r]);
          }
    }
  }
  if (MODE == 1 && bid < (nb >> 1)) qkv_items(p, smem, bid, nb);
}

__device__ __forceinline__ void hyena_channel(const Params& p, unsigned char* smem, int c) {
  u16* Zl = (u16*)smem;
  u16* R0 = (u16*)(smem + 36864);
  u16* R1 = (u16*)(smem + 36864 + 8192);
  const int tid = tidx(), lane = tid & 63, wave = __builtin_amdgcn_readfirstlane(tid >> 6);
  __syncthreads();
  if (tid == 0) { R0[0] = 0; R1[4095] = 0; }
  {
    const float w1a = p.conv_w[512 + c], w1b = p.conv_w[1536 + 512 + c], w1c = p.conv_w[3072 + 512 + c], b1 = p.conv_b[512 + c];
    const float wva = p.conv_w[1024 + c], wvb = p.conv_w[1536 + 1024 + c], wvc = p.conv_w[3072 + 1024 + c], bv = p.conv_b[1024 + c];
    const int s0 = tid * 8;
#pragma unroll 4
    for (int b = 0; b < 8; ++b) {
      const u16* u1 = p.uT + (size_t)(512 + c) * T_TOK + b * SEQ;
      const u16* uv = p.uT + (size_t)(1024 + c) * T_TOK + b * SEQ;
      U4 a = *(const U4*)(u1 + s0), d = *(const U4*)(uv + s0);
      float x[10], y[10];
      x[0] = (s0 > 0) ? bf2f(u1[s0 - 1]) : 0.f; y[0] = (s0 > 0) ? bf2f(uv[s0 - 1]) : 0.f;
      x[9] = (s0 + 8 < SEQ) ? bf2f(u1[s0 + 8]) : 0.f; y[9] = (s0 + 8 < SEQ) ? bf2f(uv[s0 + 8]) : 0.f;
      x[1] = bflo(a.x); x[2] = bfhi(a.x); x[3] = bflo(a.y); x[4] = bfhi(a.y); x[5] = bflo(a.z); x[6] = bfhi(a.z); x[7] = bflo(a.w); x[8] = bfhi(a.w);
      y[1] = bflo(d.x); y[2] = bfhi(d.x); y[3] = bflo(d.y); y[4] = bfhi(d.y); y[5] = bflo(d.z); y[6] = bfhi(d.z); y[7] = bflo(d.w); y[8] = bfhi(d.w);
      float z[8];
#pragma unroll
      for (int i = 0; i < 8; ++i) {
        float x1 = w1a * x[i] + w1b * x[i + 1] + w1c * x[i + 2] + b1;
        float vv = wva * y[i] + wvb * y[i + 1] + wvc * y[i + 2] + bv;
        z[i] = x1 * vv;
      }
      U4 o; o.x = pack2(z[0], z[1]); o.y = pack2(z[2], z[3]); o.z = pack2(z[4], z[5]); o.w = pack2(z[6], z[7]);
      *(U4*)(Zl + b * ZS + 96 + s0) = o;
      if (tid < 200) { int idx = (tid < 96) ? tid : (SEQ + tid); Zl[b * ZS + idx] = 0; }
    }
  }
  __syncthreads();
  {
    const int t0 = tid * 8;
    const U4 ff = *(const U4*)(p.filt + (size_t)c * 2048 + t0);
    const U4 fb = *(const U4*)(p.filt + (size_t)(512 + c) * 2048 + t0);
    u16 f[8], bw[8];
    f[0] = (u16)(ff.x & 0xffff); f[1] = (u16)(ff.x >> 16); f[2] = (u16)(ff.y & 0xffff); f[3] = (u16)(ff.y >> 16);
    f[4] = (u16)(ff.z & 0xffff); f[5] = (u16)(ff.z >> 16); f[6] = (u16)(ff.w & 0xffff); f[7] = (u16)(ff.w >> 16);
    bw[0] = (u16)(fb.x & 0xffff); bw[1] = (u16)(fb.x >> 16); bw[2] = (u16)(fb.y & 0xffff); bw[3] = (u16)(fb.y >> 16);
    bw[4] = (u16)(fb.z & 0xffff); bw[5] = (u16)(fb.z >> 16); bw[6] = (u16)(fb.w & 0xffff); bw[7] = (u16)(fb.w >> 16);
#pragma unroll
    for (int i = 0; i < 8; ++i) {
      const int t = t0 + i;
      R0[2048 - t] = f[i]; R1[2047 - t] = f[i];
      if (t >= 1) { R0[2048 + t] = bw[i]; R1[2047 + t] = bw[i]; }
    }
  }
  __syncthreads();
  f32x16 acc[4];
#pragma unroll
  for (int i = 0; i < 4; ++i)
#pragma unroll
    for (int j = 0; j < 16; ++j) acc[i][j] = 0.f;
  const int r = lane & 31, hh = lane >> 5;
  const int bb = r >> 2, ii = r & 3;
  {
    const unsigned* Rw = (const unsigned*)((r & 1) ? R1 : R0);
    const int abase = (2048 - r + 8 * hh - (r & 1)) >> 1;
    const u16* zb = Zl + bb * ZS + 96 + 32 * ii + 8 * hh;
    const int dlo = 16 * wave - 63, dhi = 16 * wave + 15;
#pragma unroll 1
    for (int d = dlo; d <= dhi; ++d) {
      bf16x8 a0, a1;
      {
        const unsigned* q = Rw + abase - 16 * d;
        unsigned w0 = q[0], w1 = q[1], w2 = q[2], w3 = q[3], w4 = q[8], w5 = q[9], w6 = q[10], w7 = q[11];
        typedef __attribute__((ext_vector_type(4))) unsigned u32x4;
        u32x4 t0 = {w0, w1, w2, w3}, t1 = {w4, w5, w6, w7};
        a0 = __builtin_bit_cast(bf16x8, t0); a1 = __builtin_bit_cast(bf16x8, t1);
      }
#pragma unroll
      for (int nt = 0; nt < 4; ++nt) {
        const int i0 = 16 * wave + 4 * nt;
        if (d >= i0 - 63 && d <= i0 + 3) {
          const u16* zp = zb + 32 * (i0 - d);
          bf16x8 b0 = *(const bf16x8*)(zp);
          bf16x8 b1 = *(const bf16x8*)(zp + 16);
          acc[nt] = __builtin_amdgcn_mfma_f32_32x32x16_bf16(a0, b0, acc[nt], 0, 0, 0);
          acc[nt] = __builtin_amdgcn_mfma_f32_32x32x16_bf16(a1, b1, acc[nt], 0, 0, 0);
        }
      }
    }
  }
  __syncthreads();
  {
    const float w0a = p.conv_w[c], w0b = p.conv_w[1536 + c], w0c = p.conv_w[3072 + c], b0 = p.conv_b[c];
    const int s0 = tid * 8;
#pragma unroll 8
    for (int b = 0; b < 8; ++b) {
      const u16* u0 = p.uT + (size_t)c * T_TOK + b * SEQ;
      U4 a = *(const U4*)(u0 + s0);
      float x[10];
      x[0] = (s0 > 0) ? bf2f(u0[s0 - 1]) : 0.f;
      x[9] = (s0 + 8 < SEQ) ? bf2f(u0[s0 + 8]) : 0.f;
      x[1] = bflo(a.x); x[2] = bfhi(a.x); x[3] = bflo(a.y); x[4] = bfhi(a.y); x[5] = bflo(a.z); x[6] = bfhi(a.z); x[7] = bflo(a.w); x[8] = bfhi(a.w);
      float z[8];
#pragma unroll
      for (int i = 0; i < 8; ++i) z[i] = w0a * x[i] + w0b * x[i + 1] + w0c * x[i + 2] + b0;
      U4 o; o.x = pack2(z[0], z[1]); o.y = pack2(z[2], z[3]); o.z = pack2(z[4], z[5]); o.w = pack2(z[6], z[7]);
      *(U4*)(Zl + b * ZS + 96 + s0) = o;
    }
  }
  __syncthreads();
#pragma unroll
  for (int nt = 0; nt < 4; ++nt) {
    const int i0 = 16 * wave + 4 * nt;
#pragma unroll
    for (int rg = 0; rg < 4; ++rg) {
      const int ts = 32 * (i0 + ii) + 8 * rg + 4 * hh;
      U2 xv = *(const U2*)(Zl + bb * ZS + 96 + ts);
      U2 o;
      o.x = pack2(acc[nt][rg * 4 + 0] * bflo(xv.x), acc[nt][rg * 4 + 1] * bfhi(xv.x));
      o.y = pack2(acc[nt][rg * 4 + 2] * bflo(xv.y), acc[nt][rg * 4 + 3] * bfhi(xv.y));
      *(U2*)(p.yhT + (size_t)c * T_TOK + bb * SEQ + ts) = o;
    }
  }
}

__device__ __forceinline__ void q_tile(const Params& p, unsigned char* smem, int mtile, int h) {
  u16* sA = (u16*)smem; u16* sB = (u16*)(smem + OFF_SB); float* rsq = (float*)(smem + OFF_RS);
  const int tid = tidx(), lane = tid & 63, wave = __builtin_amdgcn_readfirstlane(tid >> 6), c = lane & 15, g = lane >> 4;
  const int m0 = mtile * 128;
  __syncthreads();
  {
    const int row = tid >> 1, half = tid & 1;
    const U4* src = (const U4*)(p.cq + (size_t)(m0 + row) * 256 + half * 128);
    float ss = 0.f;
#pragma unroll
    for (int i = 0; i < 16; ++i) {
      U4 v = src[i];
      float a;
      a = bflo(v.x); ss += a * a; a = bfhi(v.x); ss += a * a; a = bflo(v.y); ss += a * a; a = bfhi(v.y); ss += a * a;
      a = bflo(v.z); ss += a * a; a = bfhi(v.z); ss += a * a; a = bflo(v.w); ss += a * a; a = bfhi(v.w); ss += a * a;
    }
    ss += __shfl_xor(ss, 1);
    if (half == 0) rsq[row] = rsqrtf(ss * (1.f / 256.f) + EPS);
  }
  f32x4 acc[2][6];
#pragma unroll
  for (int i = 0; i < 2; ++i)
#pragma unroll
    for (int j = 0; j < 6; ++j) acc[i][j] = f32x4{0.f, 0.f, 0.f, 0.f};
  gemm_main<128, 96, 4, 1, false, 128>(p.cq, 256, p.w_uqT, 256, 256, m0, h * 96, sA, sB, acc);
  const float QSCALE = 0.10206207261596575f * 1.4426950408889634f;
  const float invf = powf(10000.f, -(float)c / 16.f);
  float gn[6];
#pragma unroll
  for (int nt = 0; nt < 6; ++nt) gn[nt] = p.q_norm[nt * 16 + c];
#pragma unroll
  for (int mt = 0; mt < 2; ++mt)
#pragma unroll
    for (int r = 0; r < 4; ++r) {
      const int rl = wave * 32 + mt * 16 + g * 4 + r;
      const int t = m0 + rl; const int b = t >> 11, s = t & 2047;
      const float rs = rsq[rl];
      float q[6]; float ss = 0.f;
#pragma unroll
      for (int nt = 0; nt < 6; ++nt) { q[nt] = acc[mt][nt][r] * rs; ss += q[nt] * q[nt]; }
      ss = sum16(ss);
      const float rn = rsqrtf(ss * (1.f / 96.f) + EPS);
      u16* dst = p.Q + ((size_t)(b * 8 + h) * SEQ + s) * 96;
#pragma unroll
      for (int nt = 0; nt < 4; ++nt) dst[nt * 16 + c] = f2bf(q[nt] * rn * gn[nt] * QSCALE);
      const float x1 = q[4] * rn * gn[4], x2 = q[5] * rn * gn[5];
      float sn, cs; sincosf((float)s * invf, &sn, &cs);
      dst[64 + c] = f2bf((x1 * cs - x2 * sn) * QSCALE);
      dst[80 + c] = f2bf((x2 * cs + x1 * sn) * QSCALE);
    }
}

__device__ __forceinline__ void kv_tile(const Params& p, unsigned char* smem, int mtile, int h) {
  u16* sA = (u16*)smem; u16* sB = (u16*)(smem + OFF_SB); float* rsq = (float*)(smem + OFF_RS);
  const int tid = tidx(), lane = tid & 63, wave = __builtin_amdgcn_readfirstlane(tid >> 6), c = lane & 15, g = lane >> 4;
  const int wm = wave >> 1, wn = wave & 1;
  const int m0 = mtile * 128;
  __syncthreads();
  {
    const int row = tid >> 1, half = tid & 1;
    const U4* src = (const U4*)(p.ckv + (size_t)(m0 + row) * 160 + half * 64);
    float ss = 0.f;
#pragma unroll
    for (int i = 0; i < 8; ++i) {
      U4 v = src[i];
      float a;
      a = bflo(v.x); ss += a * a; a = bfhi(v.x); ss += a * a; a = bflo(v.y); ss += a * a; a = bfhi(v.y); ss += a * a;
      a = bflo(v.z); ss += a * a; a = bfhi(v.z); ss += a * a; a = bflo(v.w); ss += a * a; a = bfhi(v.w); ss += a * a;
    }
    ss += __shfl_xor(ss, 1);
    if (half == 0) rsq[row] = rsqrtf(ss * (1.f / 128.f) + EPS);
  }
  f32x4 acc[4][4];
#pragma unroll
  for (int i = 0; i < 4; ++i)
#pragma unroll
    for (int j = 0; j < 4; ++j) acc[i][j] = f32x4{0.f, 0.f, 0.f, 0.f};
  gemm_main<128, 128, 2, 2, false, 128>(p.ckv, 160, p.w_ukvT, 128, 128, m0, h * 128, sA, sB, acc);
  if (wn == 0) {
    const float invf = powf(10000.f, -(float)c / 16.f);
    float gn[6];
#pragma unroll
    for (int nt = 0; nt < 6; ++nt) gn[nt] = p.k_norm[nt * 16 + c];
#pragma unroll
    for (int mt = 0; mt < 4; ++mt)
#pragma unroll
      for (int r = 0; r < 4; ++r) {
        const int rl = wm * 64 + mt * 16 + g * 4 + r;
        const int t = m0 + rl; const int b = t >> 11, s = t & 2047;
        const float rs = rsq[rl];
        float kn[4]; float ss = 0.f;
#pragma unroll
        for (int nt = 0; nt < 4; ++nt) { kn[nt] = acc[mt][nt][r] * rs; ss += kn[nt] * kn[nt]; }
        const float pe1 = bf2f(p.ckv[(size_t)t * 160 + 128 + c]), pe2 = bf2f(p.ckv[(size_t)t * 160 + 144 + c]);
        ss += pe1 * pe1 + pe2 * pe2;
        ss = sum16(ss);
        const float rn = rsqrtf(ss * (1.f / 96.f) + EPS);
        u16* dst = p.K + ((size_t)(b * 8 + h) * SEQ + s) * 96;
#pragma unroll
        for (int nt = 0; nt < 4; ++nt) dst[nt * 16 + c] = f2bf(kn[nt] * rn * gn[nt]);
        const float x1 = pe1 * rn * gn[4], x2 = pe2 * rn * gn[5];
        float sn, cs; sincosf((float)s * invf, &sn, &cs);
        dst[64 + c] = f2bf(x1 * cs - x2 * sn);
        dst[80 + c] = f2bf(x2 * cs + x1 * sn);
      }
  } else {
#pragma unroll
    for (int mt = 0; mt < 4; ++mt) {
      const int rl = wm * 64 + mt * 16 + g * 4;
      const int t = m0 + rl; const int b = t >> 11, s = t & 2047;
      float rs[4];
#pragma unroll
      for (int r = 0; r < 4; ++r) rs[r] = rsq[rl + r];
#pragma unroll
      for (int nt = 0; nt < 4; ++nt) {
        const int dcol = nt * 16 + c;
        U2 o; o.x = pack2(acc[mt][nt][0] * rs[0], acc[mt][nt][1] * rs[1]); o.y = pack2(acc[mt][nt][2] * rs[2], acc[mt][nt][3] * rs[3]);
        *(U2*)(p.Vt + ((size_t)(b * 8 + h) * 64 + dcol) * SEQ + s) = o;
      }
    }
  }
}

__device__ __forceinline__ void qkv_items(const Params& p, unsigned char* smem, int bid, int nb) {
  for (int it = bid; it < 1024 + 1024; it += nb) {
    if (it < 1024) { q_tile(p, smem, it >> 3, it & 7); }
    else { int j = it - 1024; kv_tile(p, smem, j >> 3, j & 7); }
  }
}

typedef float f32x2 __attribute__((ext_vector_type(2)));
__device__ __forceinline__ void ph_expert_fp8(const float* src, unsigned char* dst, float* inv_scale, int bid, int nb) {
  const int tid = tidx(), lane = tid & 63, wave = __builtin_amdgcn_readfirstlane(tid >> 6);
  for (int r = bid * 4 + wave; r < 16384; r += nb * 4) {
    const F4* sr = (const F4*)(src + (size_t)r * 1024 + lane * 16);
    F4 v[4]; float mx = 0.f;
#pragma unroll
    for (int i = 0; i < 4; ++i) { v[i] = sr[i]; mx = fmaxf(mx, fmaxf(fmaxf(fabsf(v[i].x), fabsf(v[i].y)), fmaxf(fabsf(v[i].z), fabsf(v[i].w)))); }
#pragma unroll
    for (int o = 32; o > 0; o >>= 1) mx = fmaxf(mx, __shfl_xor(mx, o));
    const float sc = (mx > 0.f) ? 224.f / mx : 1.f;
    if (lane == 0) inv_scale[r] = (mx > 0.f) ? mx * (1.f / 224.f) : 1.f;
    U4 o;
#pragma unroll
    for (int i = 0; i < 4; ++i) {
      int w = __builtin_amdgcn_cvt_pk_fp8_f32(v[i].x * sc, v[i].y * sc, 0, false);
      w = __builtin_amdgcn_cvt_pk_fp8_f32(v[i].z * sc, v[i].w * sc, w, true);
      o[i] = (unsigned)w;
    }
    *(U4*)(dst + (size_t)r * 1024 + lane * 16) = o;
  }
}

__device__ __forceinline__ void phase3(const Params& p, unsigned char* smem, int bid, int nb) {
  constexpr int KS = 104, VS = 72;
  u16* sK = (u16*)smem;
  u16* sV = (u16*)(smem + 13312);
  const int tid = tidx(), lane = tid & 63, wave = __builtin_amdgcn_readfirstlane(tid >> 6), c = lane & 15, g = lane >> 4;
  if (bid >= (nb >> 1)) { for (int ch = bid; ch < 512; ch += nb) hyena_channel(p, smem, ch); }
  for (int it = bid; it < 1024; it += nb) {
    const int qb = it & 15, bh = it >> 4;
    const u16* Qp = p.Q + ((size_t)bh * SEQ + qb * 128 + wave * 32) * 96;
    const u16* Kp = p.K + (size_t)bh * SEQ * 96;
    const u16* Vp = p.Vt + (size_t)bh * 64 * SEQ;
    bf16x8 qf[2][3];
#pragma unroll
    for (int qt = 0; qt < 2; ++qt)
#pragma unroll
      for (int ks = 0; ks < 3; ++ks) qf[qt][ks] = *(const bf16x8*)(Qp + (size_t)(qt * 16 + c) * 96 + ks * 32 + g * 8);
    f32x4 O[4][2];
#pragma unroll
    for (int i = 0; i < 4; ++i)
#pragma unroll
      for (int j = 0; j < 2; ++j) O[i][j] = f32x4{0.f, 0.f, 0.f, 0.f};
    float mrun[2] = {-1e30f, -1e30f}, lrun[2] = {0.f, 0.f};
    U4 rk[3], rv[2];
    const int krot = (blockIdx.x >> 3) & 31;
#pragma unroll
    for (int i = 0; i < 3; ++i) { int ch = tid + i * 256; int row = ch / 12, kc = ch % 12; rk[i] = *(const U4*)(Kp + (size_t)(krot * 64 + row) * 96 + kc * 8); }
#pragma unroll
    for (int i = 0; i < 2; ++i) { int ch = tid + i * 256; int row = ch >> 3, kc = ch & 7; rv[i] = *(const U4*)(Vp + (size_t)row * SEQ + krot * 64 + kc * 8); }
    for (int kt = 0; kt < 32; ++kt) {
      __syncthreads();
#pragma unroll
      for (int i = 0; i < 3; ++i) { int ch = tid + i * 256; int row = ch / 12, kc = ch % 12; *(U4*)(sK + row * KS + kc * 8) = rk[i]; }
#pragma unroll
      for (int i = 0; i < 2; ++i) { int ch = tid + i * 256; int row = ch >> 3, kc = ch & 7; *(U4*)(sV + row * VS + kc * 8) = rv[i]; }
      __syncthreads();
      if (kt + 1 < 32) {
        const int k0 = ((kt + 1 + krot) & 31) * 64;
#pragma unroll
        for (int i = 0; i < 3; ++i) { int ch = tid + i * 256; int row = ch / 12, kc = ch % 12; rk[i] = *(const U4*)(Kp + (size_t)(k0 + row) * 96 + kc * 8); }
#pragma unroll
        for (int i = 0; i < 2; ++i) { int ch = tid + i * 256; int row = ch >> 3, kc = ch & 7; rv[i] = *(const U4*)(Vp + (size_t)row * SEQ + k0 + kc * 8); }
      }
      f32x4 S[4][2];
#pragma unroll
      for (int i = 0; i < 4; ++i)
#pragma unroll
        for (int j = 0; j < 2; ++j) S[i][j] = f32x4{0.f, 0.f, 0.f, 0.f};
#pragma unroll
      for (int ks = 0; ks < 3; ++ks)
#pragma unroll
        for (int k4 = 0; k4 < 4; ++k4) {
          bf16x8 kf = *(const bf16x8*)(sK + (k4 * 16 + c) * KS + ks * 32 + g * 8);
          S[k4][0] = __builtin_amdgcn_mfma_f32_16x16x32_bf16(kf, qf[0][ks], S[k4][0], 0, 0, 0);
          S[k4][1] = __builtin_amdgcn_mfma_f32_16x16x32_bf16(kf, qf[1][ks], S[k4][1], 0, 0, 0);
        }
      bf16x8 pf[2][2];
#pragma unroll
      for (int qt = 0; qt < 2; ++qt) {
        float mx = S[0][qt][0];
#pragma unroll
        for (int k4 = 0; k4 < 4; ++k4)
#pragma unroll
          for (int r = 0; r < 4; ++r) mx = fmaxf(mx, S[k4][qt][r]);
        mx = fmaxf(mx, __shfl_xor(mx, 16)); mx = fmaxf(mx, __shfl_xor(mx, 32));
        float mnew = mrun[qt];
        if (__any(mx > mrun[qt] + 6.f)) {
          mnew = fmaxf(mrun[qt], mx);
          const float alpha = __builtin_amdgcn_exp2f(mrun[qt] - mnew);
          mrun[qt] = mnew;
          lrun[qt] *= alpha;
#pragma unroll
          for (int dt = 0; dt < 4; ++dt)
#pragma unroll
            for (int r = 0; r < 4; ++r) O[dt][qt][r] *= alpha;
        }
        float ls = 0.f;
        float pv[16];
#pragma unroll
        for (int k4 = 0; k4 < 4; ++k4)
#pragma unroll
          for (int r = 0; r < 4; ++r) { float e = __builtin_amdgcn_exp2f(S[k4][qt][r] - mnew); pv[k4 * 4 + r] = e; ls += e; }
        lrun[qt] += ls;
#pragma unroll
        for (int kk = 0; kk < 2; ++kk) {
          typedef __attribute__((ext_vector_type(4))) unsigned u32x4;
          u32x4 w = {pack2(pv[kk * 8 + 0], pv[kk * 8 + 1]), pack2(pv[kk * 8 + 2], pv[kk * 8 + 3]),
                     pack2(pv[kk * 8 + 4], pv[kk * 8 + 5]), pack2(pv[kk * 8 + 6], pv[kk * 8 + 7])};
          pf[qt][kk] = __builtin_bit_cast(bf16x8, w);
        }
      }
#pragma unroll
      for (int kk = 0; kk < 2; ++kk)
#pragma unroll
        for (int dt = 0; dt < 4; ++dt) {
          typedef __attribute__((ext_vector_type(4))) unsigned u32x4;
          const u16* vp = sV + (dt * 16 + c) * VS + kk * 32 + g * 4;
          U2 lo = *(const U2*)vp, hi = *(const U2*)(vp + 16);
          u32x4 w = {lo.x, lo.y, hi.x, hi.y};
          bf16x8 vf = __builtin_bit_cast(bf16x8, w);
          O[dt][0] = __builtin_amdgcn_mfma_f32_16x16x32_bf16(vf, pf[0][kk], O[dt][0], 0, 0, 0);
          O[dt][1] = __builtin_amdgcn_mfma_f32_16x16x32_bf16(vf, pf[1][kk], O[dt][1], 0, 0, 0);
        }
    }
    const int b = bh >> 3, h = bh & 7;
#pragma unroll
    for (int qt = 0; qt < 2; ++qt) {
      float l = lrun[qt];
      l += __shfl_xor(l, 16); l += __shfl_xor(l, 32);
      const float inv = 1.f / l;
      const int s = qb * 128 + wave * 32 + qt * 16 + c;
      u16* dst = p.attn_out + ((size_t)(b * SEQ + s)) * 512 + h * 64;
#pragma unroll
      for (int dt = 0; dt < 4; ++dt) {
        U2 o; o.x = pack2(O[dt][qt][0] * inv, O[dt][qt][1] * inv); o.y = pack2(O[dt][qt][2] * inv, O[dt][qt][3] * inv);
        *(U2*)(dst + dt * 16 + g * 4) = o;
      }
    }
  }
  if (bid < (nb >> 1)) { for (int ch = bid; ch < 512; ch += nb) hyena_channel(p, smem, ch); }
}

__device__ __forceinline__ void phase4(const Params& p, unsigned char* smem, int bid, int nb) {
  const int tid = tidx(), lane = tid & 63, wave = __builtin_amdgcn_readfirstlane(tid >> 6);
  const int wm = wave >> 1, wn = wave & 1, c = lane & 15, g = lane >> 4;
  for (int it = bid; it < 1024; it += nb) {
    const int li_ = (it & 511) >> 3;
    const int m0 = (64 * (it >> 9) + 8 * (it & 7) + (li_ >> 3)) * 128, n0 = (li_ & 7) * 128;
    f32x4 acc[4][4];
#pragma unroll
    for (int i = 0; i < 4; ++i)
#pragma unroll
      for (int j = 0; j < 4; ++j) acc[i][j] = f32x4{0.f, 0.f, 0.f, 0.f};
    gemm_glds<128, 128, 2, 2, true>(p.attn_out, 512, p.w_oaT, 512, 512, m0, n0, smem, acc);
    const u16* gb = p.gates + (size_t)(m0 + wm * 64 + c) * 2048 + n0 + wn * 64 + g * 4;
#pragma unroll
    for (int mt = 0; mt < 4; ++mt)
#pragma unroll
      for (int nt = 0; nt < 4; ++nt) {
        const U2 ga = *(const U2*)(gb + (mt * 16) * 2048 + nt * 16);
        const U2 gh = *(const U2*)(gb + (mt * 16) * 2048 + nt * 16 + 1024);
        acc[mt][nt][0] *= bflo(ga.x) * __frcp_rn(bflo(gh.x));
        acc[mt][nt][1] *= bfhi(ga.x) * __frcp_rn(bfhi(gh.x));
        acc[mt][nt][2] *= bflo(ga.y) * __frcp_rn(bflo(gh.y));
        acc[mt][nt][3] *= bfhi(ga.y) * __frcp_rn(bfhi(gh.y));
      }
    gemm_glds_at<true>(p.yhT, T_TOK, p.w_ohT, 512, 512, m0, n0, smem, acc);
    u16* mb = p.merged + (size_t)(m0 + wm * 64 + c) * 1024 + n0 + wn * 64 + g * 4;
#pragma unroll
    for (int mt = 0; mt < 4; ++mt)
#pragma unroll
      for (int nt = 0; nt < 4; ++nt) {
        const U2 gh = *(const U2*)(gb + (mt * 16) * 2048 + nt * 16 + 1024);
        U2 o;
        o.x = pack2(acc[mt][nt][0] * bflo(gh.x), acc[mt][nt][1] * bfhi(gh.x));
        o.y = pack2(acc[mt][nt][2] * bflo(gh.y), acc[mt][nt][3] * bfhi(gh.y));
        *(U2*)(mb + (mt * 16) * 1024 + nt * 16) = o;
      }
  }
}

__device__ __forceinline__ void phase5(const Params& p, unsigned char* smem, int bid, int nb) {
  const int tid = tidx(), lane = tid & 63, wave = __builtin_amdgcn_readfirstlane(tid >> 6);
  const int wm = wave >> 1, wn = wave & 1, c = lane & 15, g = lane >> 4;
  for (int it = bid; it < 1024; it += nb) {
    const int li_ = (it & 511) >> 3;
    const int m0 = (64 * (it >> 9) + 8 * (it & 7) + (li_ >> 3)) * 128, n0 = (li_ & 7) * 128;
    f32x4 acc[4][4];
#pragma unroll
    for (int i = 0; i < 4; ++i)
#pragma unroll
      for (int j = 0; j < 4; ++j) acc[i][j] = f32x4{0.f, 0.f, 0.f, 0.f};
    gemm_glds<128, 128, 2, 2, true>(p.merged, 1024, p.w_outT, 1024, 1024, m0, n0, smem, acc);
#pragma unroll
    for (int mt = 0; mt < 4; ++mt) {
      const int t = m0 + wm * 64 + mt * 16 + c;
      float ss = 0.f;
#pragma unroll
      for (int nt = 0; nt < 4; ++nt) {
        const int n = n0 + wn * 64 + nt * 16 + g * 4;
        const F4 xv = *(const F4*)(p.x + (size_t)t * 1024 + n);
        const F4 gn = *(const F4*)(p.ffn_norm + n);
        F4 h1;
        h1.x = xv.x + acc[mt][nt][0]; h1.y = xv.y + acc[mt][nt][1]; h1.z = xv.z + acc[mt][nt][2]; h1.w = xv.w + acc[mt][nt][3];
        *(F4*)(p.out + (size_t)t * 1024 + n) = h1;
        U2 o; o.x = pack2(h1.x * gn.x, h1.y * gn.y); o.y = pack2(h1.z * gn.z, h1.w * gn.w);
        *(U2*)(p.hb + (size_t)t * 1024 + n) = o;
        ss += h1.x * h1.x + h1.y * h1.y + h1.z * h1.z + h1.w * h1.w;
      }
      ss += __shfl_xor(ss, 16); ss += __shfl_xor(ss, 32);
      if (g == 0) p.ssq2[t * 16 + (n0 >> 6) + wn] = ss;
    }
  }
}

#define KEY_INSERT(xk)                                                               \
  {                                                                                  \
    float x_ = (xk);                                                                 \
    _Pragma("unroll") for (int k_ = 0; k_ < 16; ++k_) {                              \
      const float hi_ = fmaxf(tv[k_], x_); x_ = fminf(tv[k_], x_); tv[k_] = hi_;    \
    }                                                                                \
  }

__device__ __forceinline__ void phase6(const Params& p, unsigned char* smem, int bid, int nb) {
  float* sc = (float*)smem;
  float* rsl = (float*)(smem + OFF_RS);
  const int tid = tidx(), lane = tid & 63, wave = __builtin_amdgcn_readfirstlane(tid >> 6), c = lane & 15, g = lane >> 4;
  const int wm = wave >> 1, wn = wave & 1;
  if (bid >= (nb >> 1)) { ph_expert_fp8(p.eu, p.eu8, p.eus, bid, nb); ph_expert_fp8(p.ev, p.ev8, p.evs, bid, nb); }
  for (int it = bid; it < 2048; it += nb) {
    const int li_ = (it & 511) >> 3;
    const int hs = li_ & 15, m0 = (32 * (it >> 9) + 4 * (it & 7) + (li_ >> 4)) * 128;
    __syncthreads();
    if (tid < 128) {
      const float* sq = p.ssq2 + (size_t)(m0 + tid) * 16;
      float s = 0.f;
#pragma unroll
      for (int i = 0; i < 16; ++i) s += sq[i];
      rsl[tid] = rsqrtf(s * (1.f / 1024.f) + EPS);
    }
    f32x4 acc[4][4];
#pragma unroll
    for (int i = 0; i < 4; ++i)
#pragma unroll
      for (int j = 0; j < 4; ++j) acc[i][j] = f32x4{0.f, 0.f, 0.f, 0.f};
    gemm_glds<128, 128, 2, 2>(p.hb, 1024, p.wcT, 1024, 1024, m0, hs * 128, smem, acc);
#pragma unroll
    for (int mt = 0; mt < 4; ++mt)
#pragma unroll
      for (int r = 0; r < 4; ++r) {
        const int rl = wm * 64 + mt * 16 + g * 4 + r;
        const float rstd = rsl[rl];
#pragma unroll
        for (int nt = 0; nt < 4; ++nt) {
          const int col = wn * 64 + nt * 16 + c;
          const unsigned kb = (__float_as_uint(acc[mt][nt][r] * rstd) & 0xffffff80u) | (unsigned)col;
          sc[rl * 129 + col] = __uint_as_float(kb);
        }
      }
    __syncthreads();
    float tv[16];
    const int row = tid & 127;
    float* seg = sc + row * 129 + (tid >> 7) * 64;
#pragma unroll
    for (int k = 0; k < 16; ++k) tv[k] = -3.0e38f;
#pragma unroll 8
    for (int j = 0; j < 64; ++j) { KEY_INSERT(seg[j]) }
    if (tid >= 128) {
#pragma unroll
      for (int k = 0; k < 16; ++k) seg[k] = tv[k];
    }
    __syncthreads();
    if (tid < 128) {
#pragma unroll
      for (int k = 0; k < 16; ++k) tv[k] = fmaxf(tv[k], seg[64 + 15 - k]);
#pragma unroll
      for (int st = 8; st > 0; st >>= 1)
#pragma unroll
        for (int k = 0; k < 16; ++k)
          if ((k & st) == 0) { const float hi = fmaxf(tv[k], tv[k + st]), lo = fminf(tv[k], tv[k + st]); tv[k] = hi; tv[k + st] = lo; }
      F4* dst = (F4*)(p.tk + ((size_t)(m0 + row) * 16 + hs) * 16);
      dst[0] = F4{tv[0], tv[1], tv[2], tv[3]}; dst[1] = F4{tv[4], tv[5], tv[6], tv[7]};
      dst[2] = F4{tv[8], tv[9], tv[10], tv[11]}; dst[3] = F4{tv[12], tv[13], tv[14], tv[15]};
    }
  }
  if (bid < (nb >> 1)) { ph_expert_fp8(p.eu, p.eu8, p.eus, bid, nb); ph_expert_fp8(p.ev, p.ev8, p.evs, bid, nb); }
}

__device__ __forceinline__ void combine_task(const Params& p, int task, int* oi, float* og) {
  const float* s1 = p.tk + (size_t)task * 32; const float* s2 = s1 + 16;
  float v1[16], v2[16];
#pragma unroll
  for (int k4 = 0; k4 < 4; ++k4) {
    const F4 a = ((const F4*)s1)[k4], b = ((const F4*)s2)[k4];
    v1[4 * k4] = a.x; v1[4 * k4 + 1] = a.y; v1[4 * k4 + 2] = a.z; v1[4 * k4 + 3] = a.w;
    v2[4 * k4] = b.x; v2[4 * k4 + 1] = b.y; v2[4 * k4 + 2] = b.z; v2[4 * k4 + 3] = b.w;
  }
  float tv[16];
#pragma unroll
  for (int k = 0; k < 16; ++k) tv[k] = -3.0e38f;
#pragma unroll
  for (int a = 0; a < 16; ++a)
#pragma unroll
    for (int b = 0; b < 16; ++b)
      if ((a + 1) * (b + 1) <= 16) {
        const unsigned kb = (__float_as_uint(v1[a] + v2[b]) & 0xffffff00u) | (unsigned)(a * 16 + b);
        KEY_INSERT(__uint_as_float(kb))
      }
  float es[16]; float sum = 0.f;
#pragma unroll
  for (int k = 0; k < 16; ++k) { es[k] = __expf(tv[k] - tv[0]); sum += es[k]; }
  const float inv = 1.f / sum;
#pragma unroll
  for (int k = 0; k < 16; ++k) {
    const unsigned ab = __float_as_uint(tv[k]) & 0xffu;
    const int a = ab >> 4, b = ab & 15;
    oi[k] = (int)(__float_as_uint(s1[a]) & 127u) * 128 + (int)(__float_as_uint(s2[b]) & 127u);
    og[k] = es[k] * inv;
  }
}
__device__ __forceinline__ void phase6b(const Params& p, int bid, int nb) {
  for (int task = bid * 256 + tidx(); task < T_TOK * 8; task += nb * 256)
    combine_task(p, task, p.sel_idx + (size_t)task * 16, p.sel_g + (size_t)task * 16);
}

__device__ __forceinline__ void unpack8(U4 v, float* f) {
  f[0] = bflo(v.x); f[1] = bfhi(v.x); f[2] = bflo(v.y); f[3] = bfhi(v.y);
  f[4] = bflo(v.z); f[5] = bfhi(v.z); f[6] = bflo(v.w); f[7] = bfhi(v.w);
}

__device__ __forceinline__ float dot16_fp8(U4 r, const float* hv) {
  f32x2 s2 = {0.f, 0.f};
#pragma unroll
  for (int k = 0; k < 4; ++k) {
    const f32x2 a = __builtin_amdgcn_cvt_pk_f32_fp8((int)r[k], false), b = __builtin_amdgcn_cvt_pk_f32_fp8((int)r[k], true);
    const f32x2 h0 = {hv[4 * k], hv[4 * k + 1]}, h1 = {hv[4 * k + 2], hv[4 * k + 3]};
    s2 = __builtin_elementwise_fma(a, h0, s2);
    s2 = __builtin_elementwise_fma(b, h1, s2);
  }
  return s2.x + s2.y;
}
__device__ __forceinline__ void axpy16_fp8(U4 r, float w, float* acc) {
  const f32x2 w2 = {w, w};
#pragma unroll
  for (int k = 0; k < 4; ++k) {
    const f32x2 a = __builtin_amdgcn_cvt_pk_f32_fp8((int)r[k], false), b = __builtin_amdgcn_cvt_pk_f32_fp8((int)r[k], true);
    f32x2 c0 = {acc[4 * k], acc[4 * k + 1]}, c1 = {acc[4 * k + 2], acc[4 * k + 3]};
    c0 = __builtin_elementwise_fma(w2, a, c0);
    c1 = __builtin_elementwise_fma(w2, b, c1);
    acc[4 * k] = c0.x; acc[4 * k + 1] = c0.y; acc[4 * k + 2] = c1.x; acc[4 * k + 3] = c1.y;
  }
}
#define P7_LOAD(dst, tab, bidx)                                                               \
  _Pragma("unroll") for (int j_ = 0; j_ < 8; ++j_) {                                          \
    const int e_ = (bidx) * 8 + j_;                                                           \
    const int id_ = __builtin_amdgcn_readlane((e_ < 64) ? id0 : id1, e_ & 63);                \
    dst[j_] = *(const U4*)((tab) + (size_t)id_ * 1024 + lane * 16);                           \
  }
#define P7_ACT(src, bidx)                                                                     \
  {                                                                                           \
    float d_[8];                                                                              \
    _Pragma("unroll") for (int j_ = 0; j_ < 8; ++j_) d_[j_] = dot16_fp8(src[j_], hv);         \
    float r1_[4], r2_[2];                                                                     \
    _Pragma("unroll") for (int k_ = 0; k_ < 4; ++k_) {                                        \
      const float keep_ = (lane & 32) ? d_[2 * k_ + 1] : d_[2 * k_];                          \
      const float send_ = (lane & 32) ? d_[2 * k_] : d_[2 * k_ + 1];                          \
      r1_[k_] = keep_ + __shfl_xor(send_, 32);                                                \
    }                                                                                         \
    _Pragma("unroll") for (int k_ = 0; k_ < 2; ++k_) {                                        \
      const float keep_ = (lane & 16) ? r1_[2 * k_ + 1] : r1_[2 * k_];                        \
      const float send_ = (lane & 16) ? r1_[2 * k_] : r1_[2 * k_ + 1];                        \
      r2_[k_] = keep_ + __shfl_xor(send_, 16);                                                \
    }                                                                                         \
    float r3_;                                                                                \
    {                                                                                         \
      const float keep_ = (lane & 8) ? r2_[1] : r2_[0];                                       \
      const float send_ = (lane & 8) ? r2_[0] : r2_[1];                                       \
      r3_ = keep_ + __shfl_xor(send_, 8);                                                     \
    }                                                                                         \
    r3_ += __shfl_xor(r3_, 4); r3_ += __shfl_xor(r3_, 2); r3_ += __shfl_xor(r3_, 1);          \
    if ((lane & 7) == 0) wl[(bidx) * 8 + jl] = r3_;                                           \
  }
#define P7_ACC(src, bidx)                                                                     \
  {                                                                                           \
    const F4 wa_ = *(const F4*)(wl + (bidx) * 8), wb_ = *(const F4*)(wl + (bidx) * 8 + 4);    \
    axpy16_fp8(src[0], wa_.x, acc); axpy16_fp8(src[1], wa_.y, acc);                           \
    axpy16_fp8(src[2], wa_.z, acc); axpy16_fp8(src[3], wa_.w, acc);                           \
    axpy16_fp8(src[4], wb_.x, acc); axpy16_fp8(src[5], wb_.y, acc);                           \
    axpy16_fp8(src[6], wb_.z, acc); axpy16_fp8(src[7], wb_.w, acc);                           \
  }

__device__ __forceinline__ void sort128(int& r0, int& r1, int lane) {
#pragma unroll
  for (int k = 2; k <= 128; k <<= 1) {
#pragma unroll
    for (int j = k >> 1; j > 0; j >>= 1) {
      if (j == 64) { const int lo = min(r0, r1), hi = max(r0, r1); r0 = lo; r1 = hi; }
      else {
        const bool lower = (lane & j) == 0;
        { const int pv = __shfl_xor(r0, j); const bool asc = (k == 128) || ((lane & k) == 0); r0 = (lower == asc) ? min(r0, pv) : max(r0, pv); }
        { const int pv = __shfl_xor(r1, j); const bool asc = (k == 128) || (((64 + lane) & k) == 0); r1 = (lower == asc) ? min(r1, pv) : max(r1, pv); }
      }
    }
  }
}

__device__ __forceinline__ void phase7(const Params& p, unsigned char* smem, int bid, int nb, float* outp, bool fused) {
  const int tid = tidx(), lane = tid & 63, wave = __builtin_amdgcn_readfirstlane(tid >> 6);
  float* wl0 = (float*)smem + wave * 2048;
  int* sidl0 = (int*)smem + 8192 + wave * 2048;
  const int jl = ((lane >> 3) & 1) * 4 + ((lane >> 4) & 1) * 2 + ((lane >> 5) & 1);
  const int tstep = nb * 4;
  int* selI = sidl0 + 1024; float* selG = wl0 + 1024;
  if (fused) {
    const int t = bid * 4 + wave + (lane >> 3) * tstep;
    if (t < T_TOK) combine_task(p, t * 8 + (lane & 7), selI + lane * 16, selG + lane * 16);
  }
  {
    int k = 0;
#pragma unroll 1
    for (int t = bid * 4 + wave; t < T_TOK; t += tstep, ++k) {
      float* wl = wl0 + k * 128;
      const U4* hr = (const U4*)(p.hb + (size_t)t * 1024 + lane * 16);
      float hv[16];
      unpack8(__builtin_nontemporal_load(hr), hv); unpack8(__builtin_nontemporal_load(hr + 1), hv + 8);
      float s = 0.f;
#pragma unroll
      for (int i = 0; i < 16; ++i) s += p.ssq2[(size_t)t * 16 + i];
      const float rstd = rsqrtf(s * (1.f / 1024.f) + EPS);
      int k0 = ((fused ? selI[k * 128 + lane] : p.sel_idx[(size_t)t * 128 + lane]) << 7) | lane;
      int k1 = ((fused ? selI[k * 128 + 64 + lane] : p.sel_idx[(size_t)t * 128 + 64 + lane]) << 7) | (64 + lane);
      sort128(k0, k1, lane);
      const int id0 = k0 >> 7, id1 = k1 >> 7;
      sidl0[k * 128 + lane] = id0; sidl0[k * 128 + 64 + lane] = id1;
      const float us0 = p.eus[id0] * rstd, us1 = p.eus[id1] * rstd;
      const float gv0 = (fused ? selG[k * 128 + (k0 & 127)] : p.sel_g[(size_t)t * 128 + (k0 & 127)]) * p.evs[id0];
      const float gv1 = (fused ? selG[k * 128 + (k1 & 127)] : p.sel_g[(size_t)t * 128 + (k1 & 127)]) * p.evs[id1];
      U4 ba[8], bb[8], bc[8];
      P7_LOAD(ba, p.eu8, 0)
      P7_LOAD(bb, p.eu8, 1)
#pragma unroll 1
      for (int b = 0; b < 15; b += 3) {
        const int b3 = (b + 3 < 15) ? b + 3 : 15, b4 = (b + 4 < 15) ? b + 4 : 15;
        P7_LOAD(bc, p.eu8, b + 2)
        P7_ACT(ba, b)
        P7_LOAD(ba, p.eu8, b3)
        P7_ACT(bb, b + 1)
        P7_LOAD(bb, p.eu8, b4)
        P7_ACT(bc, b + 2)
      }
      P7_ACT(ba, 15)
      {
        const float x0 = wl[lane] * us0, x1 = wl[64 + lane] * us1;
        wl[lane] = gv0 * 0.5f * x0 * (1.f + erff(x0 * 0.70710678118654752f));
        wl[64 + lane] = gv1 * 0.5f * x1 * (1.f + erff(x1 * 0.70710678118654752f));
      }
    }
  }
#define P7B_LOAD(dst, bidx)                                                                    \
  _Pragma("unroll") for (int j_ = 0; j_ < 32; ++j_) {                                          \
    const int e_ = (bidx) * 32 + j_;                                                           \
    const int id_ = __builtin_amdgcn_readlane(((bidx) < 2) ? id0 : id1, e_ & 63);              \
    dst[j_] = *(const unsigned*)(vb + (size_t)id_ * 1024);                                     \
  }
#define P7B_ACC(src, bidx)                                                                     \
  _Pragma("unroll") for (int j4_ = 0; j4_ < 8; ++j4_) {                                        \
    const F4 w4_ = *(const F4*)(wl + (bidx) * 32 + j4_ * 4);                                   \
    _Pragma("unroll") for (int jj_ = 0; jj_ < 4; ++jj_) {                                      \
      const float ws_ = w4_[jj_];                                                              \
      const f32x2 w2_ = {ws_, ws_};                                                            \
      const int r_ = (int)src[j4_ * 4 + jj_];                                                  \
      a01 = __builtin_elementwise_fma(w2_, __builtin_amdgcn_cvt_pk_f32_fp8(r_, false), a01);   \
      a23 = __builtin_elementwise_fma(w2_, __builtin_amdgcn_cvt_pk_f32_fp8(r_, true), a23);    \
    }                                                                                          \
  }
#pragma unroll 1
  for (int q = 0; q < 4; ++q) {
    const unsigned char* vb = p.ev8 + q * 256 + lane * 4;
    int k = 0;
#pragma unroll 1
    for (int t = bid * 4 + wave; t < T_TOK; t += tstep, ++k) {
      const float* wl = wl0 + k * 128;
      const int id0 = sidl0[k * 128 + lane], id1 = sidl0[k * 128 + 64 + lane];
      unsigned ra[32], rb[32], rc[32];
      f32x2 a01 = {0.f, 0.f}, a23 = {0.f, 0.f};
      P7B_LOAD(ra, 0)
      P7B_LOAD(rb, 1)
      P7B_LOAD(rc, 2)
      P7B_ACC(ra, 0)
      P7B_LOAD(ra, 3)
      P7B_ACC(rb, 1)
      P7B_ACC(rc, 2)
      P7B_ACC(ra, 3)
      F4* o = (F4*)(outp + (size_t)t * 1024 + q * 256 + lane * 4);
      F4 v = __builtin_nontemporal_load(o);
      v.x += a01.x; v.y += a01.y; v.z += a23.x; v.w += a23.y;
      __builtin_nontemporal_store(v, o);
    }
  }
#undef P7B_LOAD
#undef P7B_ACC
}

__device__ __forceinline__ void run_phase(int ph, const Params& p, unsigned char* smem, int bid, int nb) {
#ifdef ONLY_PHASE
  if (ph != ONLY_PHASE) return;
#endif
  switch (ph) {
    case 0: phase0(p, smem, lbid(), nb); break;
    case 1: phase1<0>(p, smem, lbid(), nb); break;
    case 2: phase1<1>(p, smem, lbid(), nb); break;
    case 3: phase3(p, smem, lbid(), nb); break;
    case 4: phase4(p, smem, lbid(), nb); break;
    case 5: phase5(p, smem, lbid(), nb); break;
    case 6: phase6(p, smem, lbid(), nb); break;
    default: phase7(p, smem, lbid(), nb, p.out, false); break;
  }
}

__global__ void __launch_bounds__(256, 2) mega_kernel(Params p) {
  __shared__ __attribute__((aligned(16))) unsigned char smem[SMEM_BYTES];
  __shared__ U4 xb_words;
  cg::grid_group grid = cg::this_grid();
  const int bid = blockIdx.x, nb = gridDim.x;
  if (tidx() == 0) xb_words = U4{0u, 0u, 0u, 0u};
  __syncthreads();
  (void)xcd_barrier_post(p.bar, (volatile LAS unsigned*)&xb_words);
#define XBAR() do { XcdBarrier xb_; xb_.bar = p.bar; xb_.x = xb_xcc_id(); xb_.st = (volatile LAS unsigned*)&xb_words; xcd_barrier(xb_); } while (0)
#ifdef ONLY_PHASE
  run_phase(ONLY_PHASE, p, smem, bid, nb);
  grid.sync();
  XBAR();
#else
#ifndef DUP_PHASE
#define DUP_PHASE -1
#endif
#define DUP(k, call) if (DUP_PHASE == k) { call; XBAR(); }
  phase0(p, smem, lbid(), nb);
  if (p.use_cg) grid.sync();
  XBAR();
  DUP(0, phase0(p, smem, lbid(), nb))
  phase1<0>(p, smem, lbid(), nb); XBAR();
  DUP(1, phase1<1>(p, smem, lbid(), nb))
  phase1<1>(p, smem, lbid(), nb); XBAR();
  DUP(3, phase3(p, smem, lbid(), nb))
  phase3(p, smem, lbid(), nb); XBAR();
  DUP(4, phase4(p, smem, lbid(), nb))
  phase4(p, smem, lbid(), nb); XBAR();
  DUP(5, phase5(p, smem, lbid(), nb))
  phase5(p, smem, lbid(), nb); XBAR();
  DUP(6, phase6(p, smem, lbid(), nb))
  phase6(p, smem, lbid(), nb); XBAR();
  const bool fuse6b = (nb * 32 >= T_TOK);
  if (!fuse6b) { phase6b(p, lbid(), nb); XBAR(); }
  DUP(7, phase7(p, smem, lbid(), nb, (float*)p.K, fuse6b))
  phase7(p, smem, lbid(), nb, p.out, fuse6b);
#endif
}

#if MULTI_LAUNCH
__global__ void __launch_bounds__(256, 2) phase_kernel(Params p, int ph) {
  __shared__ __attribute__((aligned(16))) unsigned char smem[SMEM_BYTES];
  run_phase(ph, p, smem, blockIdx.x, gridDim.x);
}
#endif

extern "C" void kernel_launch(void* const* d_in, const int* in_sizes, int n_in, void* d_out, int out_size, void* d_ws,
                              size_t ws_size, hipStream_t stream) {
  (void)in_sizes; (void)n_in; (void)out_size;
  Params p{};
  const float** fp = (const float**)&p;
  for (int i = 0; i < 31; ++i) fp[i] = (const float*)d_in[i];
  p.out = (float*)d_out;
  unsigned char* w = (unsigned char*)d_ws;
  const size_t MB = 1024 * 1024;
  size_t off = 0;
  unsigned char* R1 = w + off; off += 64 * MB;
  unsigned char* R2 = w + off; off += 48 * MB;
  unsigned char* R3 = w + off; off += 32 * MB;
  unsigned char* R4 = w + off; off += 24 * MB;
  unsigned char* R5 = w + off; off += 16 * MB;
  unsigned char* R6 = w + off; off += 16 * MB;
  unsigned char* R7 = w + off; off += 24 * MB;
  auto take = [&](size_t bytes) { unsigned char* q = w + off; off += (bytes + 255) & ~(size_t)255; return q; };
  p.gates = (u16*)R1; p.eub = (u16*)R1; p.evb = (u16*)(R1 + 32 * MB); p.eu8 = R1; p.ev8 = R1 + 16 * MB;
  p.uT = (u16*)R2; p.merged = (u16*)R4; p.sel_idx = (int*)(R2 + 32 * MB); p.sel_g = (float*)(R2 + 40 * MB);
  p.xb = (u16*)R3; p.Q = (u16*)R7; p.hb = (u16*)R3;
  p.K = (u16*)R4; p.Vt = (u16*)R5;
  p.cq = (u16*)R6; p.ckv = (u16*)(R6 + 8 * MB); p.attn_out = (u16*)R6; p.tk = (float*)R6;
  p.yhT = (u16*)R3;
  p.w_inT = (u16*)take((size_t)4096 * 1024 * 2);
  p.w_uqT = (u16*)take((size_t)768 * 256 * 2);
  p.w_ukvT = (u16*)take((size_t)1024 * 128 * 2);
  p.w_oaT = (u16*)take((size_t)1024 * 512 * 2);
  p.w_ohT = (u16*)take((size_t)1024 * 512 * 2);
  p.w_outT = (u16*)take((size_t)1024 * 1024 * 2);
  p.wqb = (u16*)take((size_t)1024 * 2048 * 2);
  p.keysb = (u16*)take((size_t)2 * 8 * 128 * 128 * 2);
  p.wcT = (u16*)take((size_t)2048 * 1024 * 2);
  p.h3 = (float*)take((size_t)2048 * 64 * 4);
  p.rstd1 = (float*)take((size_t)T_TOK * 4);
  p.ssq2 = (float*)take((size_t)T_TOK * 16 * 4);
  p.bar = (unsigned*)take((size_t)XCD_BAR_WORDS * 4);
  p.eus = (float*)take((size_t)16384 * 4);
  p.filt = (u16*)take((size_t)1024 * 2048 * 2);
  p.use_cg = 0; p.pad_ = 0;
  p.evs = (float*)take((size_t)16384 * 4);
  if (off > ws_size) { fprintf(stderr, "workspace too small: need %zu have %zu\n", off, ws_size); return; }

  (void)hipMemsetAsync(p.bar, 0, (size_t)XCD_BAR_WORDS * 4, stream);
#if MULTI_LAUNCH
  for (int ph = 0; ph < 8; ++ph) phase_kernel<<<dim3(512), dim3(256), 0, stream>>>(p, ph);
#else
  static int grid_blocks = 0;
  if (!grid_blocks) {
    int dev = 0, cus = 0, per_cu = 0;
    (void)hipGetDevice(&dev);
    (void)hipDeviceGetAttribute(&cus, hipDeviceAttributeMultiprocessorCount, dev);
    (void)hipOccupancyMaxActiveBlocksPerMultiprocessor(&per_cu, mega_kernel, 256, 0);
    if (per_cu > 2) per_cu = 2;
    if (per_cu < 1) per_cu = 1;
    grid_blocks = cus * per_cu;
  }
  void* args[] = {&p};
  hipError_t e = hipLaunchCooperativeKernel((void*)mega_kernel, dim3(grid_blocks), dim3(256), args, 0, stream);
  if (e != hipSuccess) fprintf(stderr, "cooperative launch failed: %s (grid %d)\n", hipGetErrorString(e), grid_blocks);
#endif
}
```

```cpp
#include <hip/hip_runtime.h>
#include <hip/hip_cooperative_groups.h>
#include <cstdio>
#include <cstdint>
namespace cg = cooperative_groups;

#ifndef MULTI_LAUNCH
#define MULTI_LAUNCH 0
#endif

typedef unsigned short u16;
typedef __attribute__((ext_vector_type(8))) short bf16x8;
typedef __attribute__((ext_vector_type(4))) float f32x4;
typedef __attribute__((ext_vector_type(16))) float f32x16;
typedef __attribute__((ext_vector_type(4))) unsigned U4;
typedef __attribute__((ext_vector_type(2))) unsigned U2;
typedef __attribute__((ext_vector_type(4))) float F4;

constexpr int T_TOK = 16384;
constexpr int SEQ = 2048;
constexpr float EPS = 1e-6f;
constexpr int SMEM_BYTES = 72192;
constexpr int OFF_SB = 34816;
constexpr int OFF_RS = 71680;
constexpr int ZS = 2248;

struct Params {
  const float *x, *attn_norm, *w_in, *b_gate, *q_a_norm, *w_uq, *kv_a_norm, *w_ukv, *q_norm, *k_norm, *w_o_attn,
      *conv_w, *conv_b, *fw1, *fb1, *fw2, *fb2, *fw3, *fb3, *fw4, *fb4, *ffreq, *hbias, *w_o_hyena, *w_out, *ffn_norm,
      *peer_wq, *keys1, *keys2, *eu, *ev;
  float* out;
  u16 *xb, *w_inT, *w_uqT, *w_ukvT, *w_oaT, *w_ohT, *w_outT, *wqb, *keysb, *wcT, *eub, *evb;
  u16 *cq, *ckv, *uT, *gates, *Q, *K, *Vt, *attn_out, *yhT, *merged, *hb;
  float *h3, *rstd1, *ssq2, *sel_g;
  int* sel_idx;
  unsigned* bar;
  unsigned char *eu8, *ev8;
  float *eus, *evs;
  u16* filt;
  float* tk;
  int use_cg; int pad_;
};

typedef __bf16 bf16x2_t __attribute__((ext_vector_type(2)));
typedef float f32x2_t __attribute__((ext_vector_type(2)));
__device__ __forceinline__ unsigned pack2(float a, float b) {
  const f32x2_t v = {a, b};
  return __builtin_bit_cast(unsigned, __builtin_convertvector(v, bf16x2_t));
}
__device__ __forceinline__ u16 f2bf(float f) { return (u16)(pack2(f, 0.f) & 0xffffu); }
__device__ __forceinline__ int tidx() { int t = threadIdx.x; asm volatile("" : "+v"(t)); return t; }
__device__ __forceinline__ int lbid() { int b = blockIdx.x; asm volatile("" : "+s"(b)); return b; }
__device__ __forceinline__ float bf2f(u16 h) { return __uint_as_float(((unsigned)h) << 16); }
__device__ __forceinline__ float bflo(unsigned w) { return __uint_as_float(w << 16); }
__device__ __forceinline__ float bfhi(unsigned w) { return __uint_as_float(w & 0xffff0000u); }
__device__ __forceinline__ float wave_sum(float v) {
#pragma unroll
  for (int o = 32; o > 0; o >>= 1) v += __shfl_xor(v, o);
  return v;
}
__device__ __forceinline__ float sum16(float v) {
  v += __shfl_xor(v, 1); v += __shfl_xor(v, 2); v += __shfl_xor(v, 4); v += __shfl_xor(v, 8);
  return v;
}


#define XB_TMO      128
#define XB_XCNT(j)  (256  + 64 * (j))
#define XB_XSUB(j)  (1280 + 64 * (j))
#define XB_XGEN(j)  (2304 + 64 * (j))
#define XB_TOP      3328
#define XB_TOPGEN   3392
#define XCD_BAR_WORDS 3456
#define XB_SPIN_CAP (1u << 22)
#define LAS __attribute__((address_space(3)))
__device__ __forceinline__ unsigned xb_ld(unsigned* p)              { return __hip_atomic_load(p, __ATOMIC_RELAXED, __HIP_MEMORY_SCOPE_AGENT); }
__device__ __forceinline__ unsigned xb_add(unsigned* p, unsigned v) { return __hip_atomic_fetch_add(p, v, __ATOMIC_RELAXED, __HIP_MEMORY_SCOPE_AGENT); }
__device__ __forceinline__ unsigned xb_xcc_id() { return (unsigned)__builtin_amdgcn_s_getreg((3 << 11) | 20) & 0xFu; }
#define XB_SPIN(cond, bar) do { unsigned _sp = 0; while (cond) { __builtin_amdgcn_s_sleep(1); \
    if ((++_sp & 255u) == 0u) { if (xb_ld(&(bar)[XB_TMO])) break; if (_sp > XB_SPIN_CAP) { atomicAdd(&(bar)[XB_TMO], 1u); break; } } } } while (0)
struct XcdBarrier { unsigned* bar; unsigned x; volatile LAS unsigned* st; };
__device__ __forceinline__ XcdBarrier xcd_barrier_post(unsigned* bar, volatile LAS unsigned* st) {
  XcdBarrier b; b.bar = bar; b.x = xb_xcc_id(); b.st = st;
  if (threadIdx.x == 0) (void)xb_add(&bar[XB_XCNT(b.x)], 1u);
  return b;
}
__device__ __forceinline__ void xcd_barrier_complete(unsigned* bar, unsigned x, unsigned& nloc, unsigned& nx) {
  const unsigned G = gridDim.x * gridDim.y * gridDim.z;
  unsigned sum, cnt, mine, sp = 0u;
  for (;;) {
    sum = 0u; cnt = 0u; mine = 0u;
#pragma unroll
    for (unsigned j = 0; j < 16; ++j) { const unsigned c = xb_ld(&bar[XB_XCNT(j)]); sum += c; cnt += (c > 0u) ? 1u : 0u; mine = (j == x) ? c : mine; }
    if (sum == G) break;
    __builtin_amdgcn_s_sleep(1);
    if ((++sp & 255u) == 0u) { if (xb_ld(&bar[XB_TMO])) break; if (sp > XB_SPIN_CAP) { atomicAdd(&bar[XB_TMO], 1u); break; } }
  }
  nloc = mine > 0u ? mine : 1u; nx = cnt > 0u ? cnt : 1u;
}
__device__ __forceinline__ void xcd_barrier(const XcdBarrier& b) {
  asm volatile("s_waitcnt vmcnt(0)" ::: "memory");
  __syncthreads();
  if (threadIdx.x == 0) {
    unsigned* bar = b.bar;
    __builtin_amdgcn_s_waitcnt(0);
    unsigned nloc = b.st[0], nx = b.st[1];
    if (nloc == 0u) { xcd_barrier_complete(bar, b.x, nloc, nx); b.st[0] = nloc; b.st[1] = nx; }
    const unsigned old = xb_add(&bar[XB_XSUB(b.x)], 1u);
    const unsigned gen = old / nloc;
    if (old + 1u == (gen + 1u) * nloc) {
      __builtin_amdgcn_fence(__ATOMIC_RELEASE, "agent");
      asm volatile("s_waitcnt vmcnt(0)" ::: "memory");
      const unsigned og = xb_add(&bar[XB_TOP], 1u);
      const unsigned tg = og / nx;
      if (og + 1u == (tg + 1u) * nx) xb_add(&bar[XB_TOPGEN], 1u);
      else XB_SPIN(xb_ld(&bar[XB_TOPGEN]) == tg, bar);
      __builtin_amdgcn_fence(__ATOMIC_ACQUIRE, "agent");
      xb_add(&bar[XB_XGEN(b.x)], 1u);
      asm volatile("s_waitcnt vmcnt(0)" ::: "memory");
    } else {
      XB_SPIN(xb_ld(&bar[XB_XGEN(b.x)]) == gen, bar);
      __builtin_amdgcn_fence(__ATOMIC_ACQUIRE, "agent");
      asm volatile("s_waitcnt vmcnt(0)" ::: "memory");
    }
  }
  __syncthreads();
}

template <int BM, int BN, int WM, int WN, bool ATRANS, int BK>
__device__ __forceinline__ void gemm_main(const u16* A, int lda, const u16* Bt, int ldb, int K, int m0, int n0,
                                          u16* sA, u16* sB, f32x4 (&acc)[BM / WM / 16][BN / WN / 16]) {
  constexpr int MT = BM / WM / 16, NTL = BN / WN / 16;
  constexpr int CPR = BK / 8;
  constexpr int LDK = BK + 8;
  constexpr int ACH = BM * CPR / 256, BCH = BN * CPR / 256;
  const int tid = tidx(), lane = tid & 63, wave = __builtin_amdgcn_readfirstlane(tid >> 6);
  const int wm = wave / WN, wn = wave % WN;
  const int c = lane & 15, g = lane >> 4;
  U4 ra[ACH], rb[BCH];
  const int nk = K / BK;
  const int krot = (int)((unsigned)(blockIdx.x >> 3) % (unsigned)nk);
#pragma unroll
  for (int i = 0; i < ACH; ++i) {
    int ch = tid + i * 256;
    if (!ATRANS) { int row = ch / CPR, kc = ch % CPR; ra[i] = *(const U4*)(A + (size_t)(m0 + row) * lda + krot * BK + kc * 8); }
    else { int k = ch / (BM / 8), mc = ch % (BM / 8); ra[i] = *(const U4*)(A + (size_t)(krot * BK + k) * lda + m0 + mc * 8); }
  }
#pragma unroll
  for (int i = 0; i < BCH; ++i) {
    int ch = tid + i * 256; int row = ch / CPR, kc = ch % CPR;
    rb[i] = *(const U4*)(Bt + (size_t)(n0 + row) * ldb + krot * BK + kc * 8);
  }
  for (int kt = 0; kt < nk; ++kt) {
    __syncthreads();
#pragma unroll
    for (int i = 0; i < ACH; ++i) {
      int ch = tid + i * 256;
      if (!ATRANS) { int row = ch / CPR, kc = ch % CPR; *(U4*)(sA + row * LDK + kc * 8) = ra[i]; }
      else {
        int k = ch / (BM / 8), mc = ch % (BM / 8);
        u16* d = sA + (mc * 8) * LDK + k;
        d[0 * LDK] = (u16)(ra[i].x & 0xffff); d[1 * LDK] = (u16)(ra[i].x >> 16);
        d[2 * LDK] = (u16)(ra[i].y & 0xffff); d[3 * LDK] = (u16)(ra[i].y >> 16);
        d[4 * LDK] = (u16)(ra[i].z & 0xffff); d[5 * LDK] = (u16)(ra[i].z >> 16);
        d[6 * LDK] = (u16)(ra[i].w & 0xffff); d[7 * LDK] = (u16)(ra[i].w >> 16);
      }
    }
#pragma unroll
    for (int i = 0; i < BCH; ++i) {
      int ch = tid + i * 256; int row = ch / CPR, kc = ch % CPR;
      *(U4*)(sB + row * LDK + kc * 8) = rb[i];
    }
    __syncthreads();
    if (kt + 1 < nk) {
      int kn = kt + 1 + krot; if (kn >= nk) kn -= nk;
      const int k0 = kn * BK;
#pragma unroll
      for (int i = 0; i < ACH; ++i) {
        int ch = tid + i * 256;
        if (!ATRANS) { int row = ch / CPR, kc = ch % CPR; ra[i] = *(const U4*)(A + (size_t)(m0 + row) * lda + k0 + kc * 8); }
        else { int k = ch / (BM / 8), mc = ch % (BM / 8); ra[i] = *(const U4*)(A + (size_t)(k0 + k) * lda + m0 + mc * 8); }
      }
#pragma unroll
      for (int i = 0; i < BCH; ++i) {
        int ch = tid + i * 256; int row = ch / CPR, kc = ch % CPR;
        rb[i] = *(const U4*)(Bt + (size_t)(n0 + row) * ldb + k0 + kc * 8);
      }
    }
#pragma unroll
    for (int ks = 0; ks < BK / 32; ++ks) {
      bf16x8 af[MT], bfr[NTL];
#pragma unroll
      for (int mt = 0; mt < MT; ++mt) af[mt] = *(const bf16x8*)(sA + (wm * (BM / WM) + mt * 16 + c) * LDK + ks * 32 + g * 8);
#pragma unroll
      for (int nt = 0; nt < NTL; ++nt) bfr[nt] = *(const bf16x8*)(sB + (wn * (BN / WN) + nt * 16 + c) * LDK + ks * 32 + g * 8);
#pragma unroll
      for (int mt = 0; mt < MT; ++mt)
#pragma unroll
        for (int nt = 0; nt < NTL; ++nt)
          acc[mt][nt] = __builtin_amdgcn_mfma_f32_16x16x32_bf16(af[mt], bfr[nt], acc[mt][nt], 0, 0, 0);
    }
  }
}


template <int BM, int BN, int WM, int WN, bool SWAP = false>
__device__ __forceinline__ void gemm_glds(const u16* A, int lda, const u16* Bt, int ldb, int K, int m0, int n0,
                                          unsigned char* smem, f32x4 (&acc)[BM / WM / 16][BN / WN / 16]) {
  constexpr int MT = BM / WM / 16, NTL = BN / WN / 16;
  constexpr int TA = BM * 128, TB = BN * 128, STAGE = TA + TB;
  constexpr int GA = BM / 32, GB = BN / 32;
  const int tid = tidx(), lane = tid & 63, wave = __builtin_amdgcn_readfirstlane(tid >> 6);
  const int wm = wave / WN, wn = wave % WN;
  const int c = lane & 15, g = lane >> 4;
  const int rg = lane >> 3, kcs = ((lane & 7) ^ rg) * 8;
  const int nk = K / 64;
  const int krot = (int)((unsigned)(blockIdx.x >> 3) % (unsigned)nk);
  const u16* asrc = A + (size_t)(m0 + wave * 8 + rg) * lda + kcs;
  const u16* bsrc = Bt + (size_t)(n0 + wave * 8 + rg) * ldb + kcs;
#define GLDS_STAGE(buf, kt)                                                                                          \
  {                                                                                                                  \
    unsigned char* sa_ = smem + (buf) * STAGE + wave * 1024;                                                         \
    _Pragma("unroll") for (int i_ = 0; i_ < GA; ++i_)                                                                \
      __builtin_amdgcn_global_load_lds((const unsigned*)(asrc + (size_t)(i_ * 32) * lda + (kt) * 64),                \
                                       (unsigned*)(sa_ + i_ * 4096), 16, 0, 0);                                      \
    _Pragma("unroll") for (int i_ = 0; i_ < GB; ++i_)                                                                \
      __builtin_amdgcn_global_load_lds((const unsigned*)(bsrc + (size_t)(i_ * 32) * ldb + (kt) * 64),                \
                                       (unsigned*)(sa_ + TA + i_ * 4096), 16, 0, 0);                                 \
  }
  __syncthreads();
  GLDS_STAGE(0, krot)
  asm volatile("s_waitcnt vmcnt(0)" ::: "memory");
  __syncthreads();
#pragma unroll 4
  for (int kt = 0; kt < nk; ++kt) {
    const int cur = kt & 1;
    int kn = kt + 1 + krot; if (kn >= nk) kn -= nk;
    if (kt + 1 < nk) GLDS_STAGE(cur ^ 1, kn)
    const unsigned char* pa = smem + cur * STAGE;
    const unsigned char* pb = pa + TA;
#pragma unroll
    for (int ks = 0; ks < 2; ++ks) {
      bf16x8 af[MT], bfr[NTL];
      const int cho = (((ks * 4 + g) ^ (c & 7)) * 16);
#pragma unroll
      for (int mt = 0; mt < MT; ++mt) af[mt] = *(const bf16x8*)(pa + (wm * (BM / WM) + mt * 16 + c) * 128 + cho);
#pragma unroll
      for (int nt = 0; nt < NTL; ++nt) bfr[nt] = *(const bf16x8*)(pb + (wn * (BN / WN) + nt * 16 + c) * 128 + cho);
#pragma unroll
      for (int mt = 0; mt < MT; ++mt)
#pragma unroll
        for (int nt = 0; nt < NTL; ++nt)
          acc[mt][nt] = SWAP ? __builtin_amdgcn_mfma_f32_16x16x32_bf16(bfr[nt], af[mt], acc[mt][nt], 0, 0, 0)
                             : __builtin_amdgcn_mfma_f32_16x16x32_bf16(af[mt], bfr[nt], acc[mt][nt], 0, 0, 0);
    }
    asm volatile("s_waitcnt vmcnt(0)" ::: "memory");
    __syncthreads();
  }
#undef GLDS_STAGE
}

template <bool SWAP>
__device__ __forceinline__ void gemm_glds_at(const u16* At, int ldat, const u16* Bt, int ldb, int K, int m0, int n0,
                                             unsigned char* smem, f32x4 (&acc)[4][4]) {
  constexpr int IA = 1040, TA = 16 * IA, TB = 128 * 128, STAGE = TA + TB;
  const int tid = tidx(), lane = tid & 63, wave = __builtin_amdgcn_readfirstlane(tid >> 6);
  const int wm = wave >> 1, wn = wave & 1;
  const int c = lane & 15, g = lane >> 4;
  const int rg = lane >> 3, kcs = ((lane & 7) ^ rg) * 8;
  const int nk = K / 64;
  const int krot = (int)((unsigned)(blockIdx.x >> 3) % (unsigned)nk);
  const u16* asrc = At + (size_t)(wave * 4 + (lane >> 4)) * ldat + m0 + (lane & 15) * 8;
  const u16* bsrc = Bt + (size_t)(n0 + wave * 8 + rg) * ldb + kcs;
#define GLDS_STAGE_AT(buf, kt)                                                                                       \
  {                                                                                                                  \
    unsigned char* sa_ = smem + (buf) * STAGE;                                                                       \
    _Pragma("unroll") for (int i_ = 0; i_ < 4; ++i_)                                                                 \
      __builtin_amdgcn_global_load_lds((const unsigned*)(asrc + (size_t)((kt) * 64 + i_ * 16) * ldat),               \
                                       (unsigned*)(sa_ + (wave + i_ * 4) * IA), 16, 0, 0);                           \
    _Pragma("unroll") for (int i_ = 0; i_ < 4; ++i_)                                                                 \
      __builtin_amdgcn_global_load_lds((const unsigned*)(bsrc + (size_t)(i_ * 32) * ldb + (kt) * 64),                \
                                       (unsigned*)(sa_ + TA + wave * 1024 + i_ * 4096), 16, 0, 0);                   \
  }
  __syncthreads();
  GLDS_STAGE_AT(0, krot)
  asm volatile("s_waitcnt vmcnt(0)" ::: "memory");
  __syncthreads();
#pragma unroll 2
  for (int kt = 0; kt < nk; ++kt) {
    const int cur = kt & 1;
    int kn = kt + 1 + krot; if (kn >= nk) kn -= nk;
    if (kt + 1 < nk) GLDS_STAGE_AT(cur ^ 1, kn)
    const unsigned char* pa = smem + cur * STAGE;
    const unsigned char* pb = pa + TA;
#pragma unroll
    for (int ks = 0; ks < 2; ++ks) {
      bf16x8 af[4], bfr[4];
      const int cho = (((ks * 4 + g) ^ (c & 7)) * 16);
#pragma unroll
      for (int mt = 0; mt < 4; ++mt) {
        const unsigned char* q = pa + (ks * 8 + 2 * g) * IA + (wm * 64 + mt * 16 + c) * 2;
        const unsigned e0 = *(const u16*)(q), e1 = *(const u16*)(q + 256), e2 = *(const u16*)(q + 512), e3 = *(const u16*)(q + 768);
        const unsigned e4 = *(const u16*)(q + IA), e5 = *(const u16*)(q + IA + 256), e6 = *(const u16*)(q + IA + 512), e7 = *(const u16*)(q + IA + 768);
        U4 w = {e0 | (e1 << 16), e2 | (e3 << 16), e4 | (e5 << 16), e6 | (e7 << 16)};
        af[mt] = __builtin_bit_cast(bf16x8, w);
      }
#pragma unroll
      for (int nt = 0; nt < 4; ++nt) bfr[nt] = *(const bf16x8*)(pb + (wn * 64 + nt * 16 + c) * 128 + cho);
#pragma unroll
      for (int mt = 0; mt < 4; ++mt)
#pragma unroll
        for (int nt = 0; nt < 4; ++nt)
          acc[mt][nt] = SWAP ? __builtin_amdgcn_mfma_f32_16x16x32_bf16(bfr[nt], af[mt], acc[mt][nt], 0, 0, 0)
                             : __builtin_amdgcn_mfma_f32_16x16x32_bf16(af[mt], bfr[nt], acc[mt][nt], 0, 0, 0);
    }
    asm volatile("s_waitcnt vmcnt(0)" ::: "memory");
    __syncthreads();
  }
#undef GLDS_STAGE_AT
}

__device__ __forceinline__ void ph_x_prep(const Params& p, int bid, int nb) {
  const int lane = tidx() & 63, wave = __builtin_amdgcn_readfirstlane(tidx() >> 6);
  for (int r = (bid * 4 + wave) * 2; r < T_TOK; r += nb * 8) {
    const F4* xr = (const F4*)(p.x + (size_t)r * 1024);
    F4 v[8]; float ss0 = 0.f, ss1 = 0.f;
#pragma unroll
    for (int i = 0; i < 8; ++i) v[i] = xr[lane + 64 * i];
#pragma unroll
    for (int i = 0; i < 4; ++i) {
      ss0 += v[i].x * v[i].x + v[i].y * v[i].y + v[i].z * v[i].z + v[i].w * v[i].w;
      ss1 += v[4 + i].x * v[4 + i].x + v[4 + i].y * v[4 + i].y + v[4 + i].z * v[4 + i].z + v[4 + i].w * v[4 + i].w;
    }
    ss0 = wave_sum(ss0); ss1 = wave_sum(ss1);
    if (lane == 0) { p.rstd1[r] = rsqrtf(ss0 * (1.f / 1024.f) + EPS); p.rstd1[r + 1] = rsqrtf(ss1 * (1.f / 1024.f) + EPS); }
#pragma unroll
    for (int i = 0; i < 8; ++i) {
      const F4 g4 = ((const F4*)p.attn_norm)[lane + 64 * (i & 3)];
      U2 o; o.x = pack2(v[i].x * g4.x, v[i].y * g4.y); o.y = pack2(v[i].z * g4.z, v[i].w * g4.w);
      ((U2*)(p.xb + (size_t)r * 1024))[lane + 64 * i] = o;
    }
  }
}

__device__ __forceinline__ void ph_transpose(const float* W, int K, int N, int Npad, u16* Wt, const float* ks, float* tile, int bid, int nb) {
  const int ntk = K / 64, ntn = Npad / 64;
  for (int it = bid; it < ntk * ntn; it += nb) {
    const int kt = it % ntk, nt = it / ntk; const int k0 = kt * 64, n0 = nt * 64;
    __syncthreads();
    for (int e = tidx(); e < 4096; e += 256) {
      int i = e >> 6, j = e & 63; int n = n0 + j;
      float v = (n < N) ? W[(size_t)(k0 + i) * N + n] : 0.f;
      if (ks) v *= ks[k0 + i];
      tile[i * 65 + j] = v;
    }
    __syncthreads();
    for (int e = tidx(); e < 4096; e += 256) {
      int j = e >> 6, i = e & 63;
      Wt[(size_t)(n0 + j) * K + k0 + i] = f2bf(tile[i * 65 + j]);
    }
  }
}

__device__ __forceinline__ void ph_convert(const float* src, u16* dst, size_t n4, int bid, int nb) {
  for (size_t i = (size_t)bid * 256 + tidx(); i < n4; i += (size_t)nb * 256) {
    F4 v = ((const F4*)src)[i];
    U2 o; o.x = pack2(v.x, v.y); o.y = pack2(v.z, v.w);
    ((U2*)dst)[i] = o;
  }
}

__device__ __forceinline__ void ph_filter_trunk(const Params& p, float* sm, int bid, int nb) {
  const int sub = __builtin_amdgcn_readfirstlane(tidx() >> 6), o = tidx() & 63;
  float* bufA = sm + sub * 128; float* bufB = bufA + 64;
  const float fr = p.ffreq[o];
  for (int it = bid; it < 512; it += nb) {
    const int t = it * 4 + sub;
    __syncthreads();
    if (o < 33) {
      float zv;
      if (o == 0) zv = (float)t / 2047.f;
      else {
        int i = (o - 1) & 15;
        float f = 1e-4f + (float)i * ((15.f - 1e-4f) / 15.f);
        float w = 6.283185307179586f * (float)t / 2048.f;
        float a = f * w;
        zv = (o <= 16) ? cosf(a) : -sinf(a);
      }
      bufA[o] = zv;
    }
    __syncthreads();
    float s = p.fb1[o];
#pragma unroll 11
    for (int k = 0; k < 33; ++k) s += bufA[k] * p.fw1[k * 64 + o];
    bufB[o] = sinf(fr * s);
    __syncthreads();
    s = p.fb2[o];
#pragma unroll 16
    for (int k = 0; k < 64; ++k) s += bufB[k] * p.fw2[k * 64 + o];
    bufA[o] = sinf(fr * s);
    __syncthreads();
    s = p.fb3[o];
#pragma unroll 16
    for (int k = 0; k < 64; ++k) s += bufA[k] * p.fw3[k * 64 + o];
    p.h3[t * 64 + o] = sinf(fr * s);
  }
}

__device__ __forceinline__ void phase0(const Params& p, unsigned char* smem, int bid, int nb) {
  float* tile = (float*)smem;
  ph_x_prep(p, bid, nb);
  ph_transpose(p.w_in, 1024, 4000, 4096, p.w_inT, nullptr, tile, bid, nb);
  ph_transpose(p.w_uq, 256, 768, 768, p.w_uqT, p.q_a_norm, tile, (bid + 64) % nb, nb);
  ph_transpose(p.w_ukv, 128, 1024, 1024, p.w_ukvT, p.kv_a_norm, tile, (bid + 128) % nb, nb);
  ph_transpose(p.w_o_attn, 512, 1024, 1024, p.w_oaT, nullptr, tile, (bid + 160) % nb, nb);
  ph_transpose(p.w_o_hyena, 512, 1024, 1024, p.w_ohT, nullptr, tile, (bid + 32) % nb, nb);
  ph_transpose(p.w_out, 1024, 1024, 1024, p.w_outT, nullptr, tile, (bid + 96) % nb, nb);
  ph_convert(p.peer_wq, p.wqb, (size_t)1024 * 2048 / 4, bid, nb);
  ph_convert(p.keys1, p.keysb, (size_t)8 * 128 * 128 / 4, bid, nb);
  ph_convert(p.keys2, p.keysb + 8 * 128 * 128, (size_t)8 * 128 * 128 / 4, bid, nb);
  __syncthreads();
  ph_filter_trunk(p, tile, nb - 1 - bid, nb);
}

__device__ __forceinline__ void filter_item(const Params& p, unsigned char* smem, int j) {
  const int tid = tidx();
  const int cp = (j & 3) * 256 + tid, t0 = (j >> 2) * 8;
  const int c = cp & 511;
  float* hl = (float*)smem;
  __syncthreads();
  {
    const float2 v = *(const float2*)(p.h3 + (size_t)t0 * 64 + tid * 2);
    hl[tid * 2] = v.x; hl[tid * 2 + 1] = v.y;
  }
  float w[64];
#pragma unroll
  for (int k = 0; k < 64; ++k) w[k] = p.fw4[k * 1024 + cp];
  const float dmin = -3.0701134573253943f, dmax = -15.350567286626972f;
  const float delta = fabsf(dmin + (float)c * ((dmax - dmin) / 511.f));
  const float b4 = p.fb4[cp];
  __syncthreads();
  float o[8];
#pragma unroll
  for (int i = 0; i < 8; ++i) {
    const int t = t0 + i;
    float sacc = 0.f;
#pragma unroll
    for (int k4 = 0; k4 < 16; ++k4) { const F4 hv = *(const F4*)(hl + i * 64 + k4 * 4); sacc += hv.x * w[k4 * 4] + hv.y * w[k4 * 4 + 1] + hv.z * w[k4 * 4 + 2] + hv.w * w[k4 * 4 + 3]; }
    float v = (sacc + b4) * expf(-((float)t / 2047.f) * delta);
    if (t == 0 && cp < 512) v += p.hbias[c];
    o[i] = v;
  }
  U4 ov; ov.x = pack2(o[0], o[1]); ov.y = pack2(o[2], o[3]); ov.z = pack2(o[4], o[5]); ov.w = pack2(o[6], o[7]);
  *(U4*)(p.filt + (size_t)cp * 2048 + t0) = ov;
}

__device__ __forceinline__ void qkv_items(const Params& p, unsigned char* smem, int bid, int nb);
template <int MODE>
__device__ __forceinline__ void phase1(const Params& p, unsigned char* smem, int bid, int nb) {
  const int lane = tidx() & 63, wave = __builtin_amdgcn_readfirstlane(tidx() >> 6);
  const int wm = wave >> 1, wn = wave & 1, c = lane & 15, g = lane >> 4;
  const int NTILES = (MODE == 0) ? 512 : 3584;
  const int NITEMS = (MODE == 0) ? NTILES : NTILES + 128 + 1024;
  if (MODE == 1 && bid >= (nb >> 1)) qkv_items(p, smem, bid, nb);
  for (int it = bid; it < NITEMS; it += nb) {
    if (it >= NTILES + 128) { filter_item(p, smem, it - NTILES - 128); continue; }
    f32x4 acc[4][4];
#pragma unroll
    for (int i = 0; i < 4; ++i)
#pragma unroll
      for (int j = 0; j < 4; ++j) acc[i][j] = f32x4{0.f, 0.f, 0.f, 0.f};
    if (it < NTILES) {
      const int rr_ = it >> 9, xx_ = it & 7, li_ = (it & 511) >> 3;
      const int ntile = ((MODE == 0) ? 0 : 4 + 4 * rr_) + (li_ >> 4);
      const int m0 = (16 * xx_ + (li_ & 15)) * 128, n0 = ntile * 128;
      if (ntile < 3 || ntile >= 16) {
        gemm_glds<128, 128, 2, 2, true>(p.xb, 1024, p.w_inT, 1024, 1024, m0, n0, smem, acc);
#pragma unroll
        for (int mt = 0; mt < 4; ++mt) {
          const int t = m0 + wm * 64 + mt * 16 + c;
          const float rs = p.rstd1[t];
#pragma unroll
          for (int nt = 0; nt < 4; ++nt) {
            const int n = n0 + wn * 64 + nt * 16 + g * 4;
            float v[4];
#pragma unroll
            for (int r = 0; r < 4; ++r) v[r] = acc[mt][nt][r] * rs;
            if (ntile < 2) {
              U2 o; o.x = pack2(v[0], v[1]); o.y = pack2(v[2], v[3]);
              *(U2*)(p.cq + (size_t)t * 256 + n) = o;
            } else if (ntile == 2) {
              U2 o; o.x = pack2(v[0], v[1]); o.y = pack2(v[2], v[3]);
              *(U2*)(p.ckv + (size_t)t * 160 + (n - 256)) = o;
            } else if (n < 4000) {
              const F4 bg = *(const F4*)(p.b_gate + (n - 1952));
              const float s0 = 1.f / (1.f + __expf(-(v[0] + bg.x))), s1 = 1.f / (1.f + __expf(-(v[1] + bg.y)));
              const float s2 = 1.f / (1.f + __expf(-(v[2] + bg.z))), s3 = 1.f / (1.f + __expf(-(v[3] + bg.w)));
              U2 o; o.x = pack2(s0, s1); o.y = pack2(s2, s3);
              *(U2*)(p.gates + (size_t)t * 2048 + (n - 1952)) = o;
            }
          }
        }
        continue;
      }
      gemm_glds<128, 128, 2, 2>(p.xb, 1024, p.w_inT, 1024, 1024, m0, n0, smem, acc);
#pragma unroll
      for (int mt = 0; mt < 4; ++mt) {
        const int t0 = m0 + wm * 64 + mt * 16 + g * 4;
        float rs[4];
#pragma unroll
        for (int r = 0; r < 4; ++r) rs[r] = p.rstd1[t0 + r];
#pragma unroll
        for (int nt = 0; nt < 4; ++nt) {
          const int nb0 = n0 + wn * 64 + nt * 16;
          const int n = nb0 + c;
          float v[4];
#pragma unroll
          for (int r = 0; r < 4; ++r) v[r] = acc[mt][nt][r] * rs[r];
          if (nb0 < 256) {
#pragma unroll
            for (int r = 0; r < 4; ++r) p.cq[(size_t)(t0 + r) * 256 + n] = f2bf(v[r]);
          } else if (nb0 < 416) {
#pragma unroll
            for (int r = 0; r < 4; ++r) p.ckv[(size_t)(t0 + r) * 160 + (n - 256)] = f2bf(v[r]);
          } else if (nb0 < 1952) {
            U2 o; o.x = pack2(v[0], v[1]); o.y = pack2(v[2], v[3]);
            *(U2*)(p.uT + (size_t)(n - 416) * T_TOK + t0) = o;
          } else if (nb0 < 4000) {
            const float bg = p.b_gate[n - 1952];
#pragma unroll
            for (int r = 0; r < 4; ++r) {
              float s = 1.f / (1.f + __expf(-(v[r] + bg)));
              p.gates[(size_t)(t0 + r) * 2048 + (n - 1952)] = f2bf(s);
            }
          }
        }
      }
    } else {
      const int j = it - NTILES; const int hs = j >> 3, kt = j & 7; const int h = hs >> 1, side = hs & 1;
      const u16* A = p.keysb + (size_t)((side * 8 + h) * 128) * 128;
      const u16* Bt = p.wqb + h * 256 + side * 128;
      gemm_glds<128, 128, 2, 2>(A, 128, Bt, 2048, 128, 0, kt * 128, smem, acc);
#pragma unroll
      for (int mt = 0; mt < 4; ++mt)
#pragma unroll
        for (int nt = 0; nt < 4; ++nt)
#pragma unroll
          for (int r = 0; r < 4; ++r) {
            int key = wm * 64 + mt * 16 + g * 4 + r; int k = kt * 128 + wn * 64 + nt * 16 + c;
            p.wcT[(size_t)(h * 256 + side * 128 + key) * 1024 + k] = f2bf(acc[mt][nt][r]);
          }
    }
  }
  if (MODE == 1 && bid < (nb >> 1)) qkv_items(p, smem, bid, nb);
}

__device__ __forceinline__ void hyena_channel(const Params& p, unsigned char* smem, int c) {
  u16* Zl = (u16*)smem;
  u16* R0 = (u16*)(smem + 36864);
  u16* R1 = (u16*)(smem + 36864 + 8192);
  const int tid = tidx(), lane = tid & 63, wave = __builtin_amdgcn_readfirstlane(tid >> 6);
  __syncthreads();
  if (tid == 0) { R0[0] = 0; R1[4095] = 0; }
  {
    const float w1a = p.conv_w[512 + c], w1b = p.conv_w[1536 + 512 + c], w1c = p.conv_w[3072 + 512 + c], b1 = p.conv_b[512 + c];
    const float wva = p.conv_w[1024 + c], wvb = p.conv_w[1536 + 1024 + c], wvc = p.conv_w[3072 + 1024 + c], bv = p.conv_b[1024 + c];
    const int s0 = tid * 8;
#pragma unroll 4
    for (int b = 0; b < 8; ++b) {
      const u16* u1 = p.uT + (size_t)(512 + c) * T_TOK + b * SEQ;
      const u16* uv = p.uT + (size_t)(1024 + c) * T_TOK + b * SEQ;
      U4 a = *(const U4*)(u1 + s0), d = *(const U4*)(uv + s0);
      float x[10], y[10];
      x[0] = (s0 > 0) ? bf2f(u1[s0 - 1]) : 0.f; y[0] = (s0 > 0) ? bf2f(uv[s0 - 1]) : 0.f;
      x[9] = (s0 + 8 < SEQ) ? bf2f(u1[s0 + 8]) : 0.f; y[9] = (s0 + 8 < SEQ) ? bf2f(uv[s0 + 8]) : 0.f;
      x[1] = bflo(a.x); x[2] = bfhi(a.x); x[3] = bflo(a.y); x[4] = bfhi(a.y); x[5] = bflo(a.z); x[6] = bfhi(a.z); x[7] = bflo(a.w); x[8] = bfhi(a.w);
      y[1] = bflo(d.x); y[2] = bfhi(d.x); y[3] = bflo(d.y); y[4] = bfhi(d.y); y[5] = bflo(d.z); y[6] = bfhi(d.z); y[7] = bflo(d.w); y[8] = bfhi(d.w);
      float z[8];
#pragma unroll
      for (int i = 0; i < 8; ++i) {
        float x1 = w1a * x[i] + w1b * x[i + 1] + w1c * x[i + 2] + b1;
        float vv = wva * y[i] + wvb * y[i + 1] + wvc * y[i + 2] + bv;
        z[i] = x1 * vv;
      }
      U4 o; o.x = pack2(z[0], z[1]); o.y = pack2(z[2], z[3]); o.z = pack2(z[4], z[5]); o.w = pack2(z[6], z[7]);
      *(U4*)(Zl + b * ZS + 96 + s0) = o;
      if (tid < 200) { int idx = (tid < 96) ? tid : (SEQ + tid); Zl[b * ZS + idx] = 0; }
    }
  }
  __syncthreads();
  {
    const int t0 = tid * 8;
    const U4 ff = *(const U4*)(p.filt + (size_t)c * 2048 + t0);
    const U4 fb = *(const U4*)(p.filt + (size_t)(512 + c) * 2048 + t0);
    u16 f[8], bw[8];
    f[0] = (u16)(ff.x & 0xffff); f[1] = (u16)(ff.x >> 16); f[2] = (u16)(ff.y & 0xffff); f[3] = (u16)(ff.y >> 16);
    f[4] = (u16)(ff.z & 0xffff); f[5] = (u16)(ff.z >> 16); f[6] = (u16)(ff.w & 0xffff); f[7] = (u16)(ff.w >> 16);
    bw[0] = (u16)(fb.x & 0xffff); bw[1] = (u16)(fb.x >> 16); bw[2] = (u16)(fb.y & 0xffff); bw[3] = (u16)(fb.y >> 16);
    bw[4] = (u16)(fb.z & 0xffff); bw[5] = (u16)(fb.z >> 16); bw[6] = (u16)(fb.w & 0xffff); bw[7] = (u16)(fb.w >> 16);
#pragma unroll
    for (int i = 0; i < 8; ++i) {
      const int t = t0 + i;
      R0[2048 - t] = f[i]; R1[2047 - t] = f[i];
      if (t >= 1) { R0[2048 + t] = bw[i]; R1[2047 + t] = bw[i]; }
    }
  }
  __syncthreads();
  f32x16 acc[4];
#pragma unroll
  for (int i = 0; i < 4; ++i)
#pragma unroll
    for (int j = 0; j < 16; ++j) acc[i][j] = 0.f;
  const int r = lane & 31, hh = lane >> 5;
  const int bb = r >> 2, ii = r & 3;
  {
    const unsigned* Rw = (const unsigned*)((r & 1) ? R1 : R0);
    const int abase = (2048 - r + 8 * hh - (r & 1)) >> 1;
    const u16* zb = Zl + bb * ZS + 96 + 32 * ii + 8 * hh;
    const int dlo = 16 * wave - 63, dhi = 16 * wave + 15;
#pragma unroll 1
    for (int d = dlo; d <= dhi; ++d) {
      bf16x8 a0, a1;
      {
        const unsigned* q = Rw + abase - 16 * d;
        unsigned w0 = q[0], w1 = q[1], w2 = q[2], w3 = q[3], w4 = q[8], w5 = q[9], w6 = q[10], w7 = q[11];
        typedef __attribute__((ext_vector_type(4))) unsigned u32x4;
        u32x4 t0 = {w0, w1, w2, w3}, t1 = {w4, w5, w6, w7};
        a0 = __builtin_bit_cast(bf16x8, t0); a1 = __builtin_bit_cast(bf16x8, t1);
      }
#pragma unroll
      for (int nt = 0; nt < 4; ++nt) {
        const int i0 = 16 * wave + 4 * nt;
        if (d >= i0 - 63 && d <= i0 + 3) {
          const u16* zp = zb + 32 * (i0 - d);
          bf16x8 b0 = *(const bf16x8*)(zp);
          bf16x8 b1 = *(const bf16x8*)(zp + 16);
          acc[nt] = __builtin_amdgcn_mfma_f32_32x32x16_bf16(a0, b0, acc[nt], 0, 0, 0);
          acc[nt] = __builtin_amdgcn_mfma_f32_32x32x16_bf16(a1, b1, acc[nt], 0, 0, 0);
        }
      }
    }
  }
  __syncthreads();
  {
    const float w0a = p.conv_w[c], w0b = p.conv_w[1536 + c], w0c = p.conv_w[3072 + c], b0 = p.conv_b[c];
    const int s0 = tid * 8;
#pragma unroll 8
    for (int b = 0; b < 8; ++b) {
      const u16* u0 = p.uT + (size_t)c * T_TOK + b * SEQ;
      U4 a = *(const U4*)(u0 + s0);
      float x[10];
      x[0] = (s0 > 0) ? bf2f(u0[s0 - 1]) : 0.f;
      x[9] = (s0 + 8 < SEQ) ? bf2f(u0[s0 + 8]) : 0.f;
      x[1] = bflo(a.x); x[2] = bfhi(a.x); x[3] = bflo(a.y); x[4] = bfhi(a.y); x[5] = bflo(a.z); x[6] = bfhi(a.z); x[7] = bflo(a.w); x[8] = bfhi(a.w);
      float z[8];
#pragma unroll
      for (int i = 0; i < 8; ++i) z[i] = w0a * x[i] + w0b * x[i + 1] + w0c * x[i + 2] + b0;
      U4 o; o.x = pack2(z[0], z[1]); o.y = pack2(z[2], z[3]); o.z = pack2(z[4], z[5]); o.w = pack2(z[6], z[7]);
      *(U4*)(Zl + b * ZS + 96 + s0) = o;
    }
  }
  __syncthreads();
#pragma unroll
  for (int nt = 0; nt < 4; ++nt) {
    const int i0 = 16 * wave + 4 * nt;
#pragma unroll
    for (int rg = 0; rg < 4; ++rg) {
      const int ts = 32 * (i0 + ii) + 8 * rg + 4 * hh;
      U2 xv = *(const U2*)(Zl + bb * ZS + 96 + ts);
      U2 o;
      o.x = pack2(acc[nt][rg * 4 + 0] * bflo(xv.x), acc[nt][rg * 4 + 1] * bfhi(xv.x));
      o.y = pack2(acc[nt][rg * 4 + 2] * bflo(xv.y), acc[nt][rg * 4 + 3] * bfhi(xv.y));
      *(U2*)(p.yhT + (size_t)c * T_TOK + bb * SEQ + ts) = o;
    }
  }
}

__device__ __forceinline__ void q_tile(const Params& p, unsigned char* smem, int mtile, int h) {
  u16* sA = (u16*)smem; u16* sB = (u16*)(smem + OFF_SB); float* rsq = (float*)(smem + OFF_RS);
  const int tid = tidx(), lane = tid & 63, wave = __builtin_amdgcn_readfirstlane(tid >> 6), c = lane & 15, g = lane >> 4;
  const int m0 = mtile * 128;
  __syncthreads();
  {
    const int row = tid >> 1, half = tid & 1;
    const U4* src = (const U4*)(p.cq + (size_t)(m0 + row) * 256 + half * 128);
    float ss = 0.f;
#pragma unroll
    for (int i = 0; i < 16; ++i) {
      U4 v = src[i];
      float a;
      a = bflo(v.x); ss += a * a; a = bfhi(v.x); ss += a * a; a = bflo(v.y); ss += a * a; a = bfhi(v.y); ss += a * a;
      a = bflo(v.z); ss += a * a; a = bfhi(v.z); ss += a * a; a = bflo(v.w); ss += a * a; a = bfhi(v.w); ss += a * a;
    }
    ss += __shfl_xor(ss, 1);
    if (half == 0) rsq[row] = rsqrtf(ss * (1.f / 256.f) + EPS);
  }
  f32x4 acc[2][6];
#pragma unroll
  for (int i = 0; i < 2; ++i)
#pragma unroll
    for (int j = 0; j < 6; ++j) acc[i][j] = f32x4{0.f, 0.f, 0.f, 0.f};
  gemm_main<128, 96, 4, 1, false, 128>(p.cq, 256, p.w_uqT, 256, 256, m0, h * 96, sA, sB, acc);
  const float QSCALE = 0.10206207261596575f * 1.4426950408889634f;
  const float invf = powf(10000.f, -(float)c / 16.f);
  float gn[6];
#pragma unroll
  for (int nt = 0; nt < 6; ++nt) gn[nt] = p.q_norm[nt * 16 + c];
#pragma unroll
  for (int mt = 0; mt < 2; ++mt)
#pragma unroll
    for (int r = 0; r < 4; ++r) {
      const int rl = wave * 32 + mt * 16 + g * 4 + r;
      const int t = m0 + rl; const int b = t >> 11, s = t & 2047;
      const float rs = rsq[rl];
      float q[6]; float ss = 0.f;
#pragma unroll
      for (int nt = 0; nt < 6; ++nt) { q[nt] = acc[mt][nt][r] * rs; ss += q[nt] * q[nt]; }
      ss = sum16(ss);
      const float rn = rsqrtf(ss * (1.f / 96.f) + EPS);
      u16* dst = p.Q + ((size_t)(b * 8 + h) * SEQ + s) * 96;
#pragma unroll
      for (int nt = 0; nt < 4; ++nt) dst[nt * 16 + c] = f2bf(q[nt] * rn * gn[nt] * QSCALE);
      const float x1 = q[4] * rn * gn[4], x2 = q[5] * rn * gn[5];
      float sn, cs; sincosf((float)s * invf, &sn, &cs);
      dst[64 + c] = f2bf((x1 * cs - x2 * sn) * QSCALE);
      dst[80 + c] = f2bf((x2 * cs + x1 * sn) * QSCALE);
    }
}

__device__ __forceinline__ void kv_tile(const Params& p, unsigned char* smem, int mtile, int h) {
  u16* sA = (u16*)smem; u16* sB = (u16*)(smem + OFF_SB); float* rsq = (float*)(smem + OFF_RS);
  const int tid = tidx(), lane = tid & 63, wave = __builtin_amdgcn_readfirstlane(tid >> 6), c = lane & 15, g = lane >> 4;
  const int wm = wave >> 1, wn = wave & 1;
  const int m0 = mtile * 128;
  __syncthreads();
  {
    const int row = tid >> 1, half = tid & 1;
    const U4* src = (const U4*)(p.ckv + (size_t)(m0 + row) * 160 + half * 64);
    float ss = 0.f;
#pragma unroll
    for (int i = 0; i < 8; ++i) {
      U4 v = src[i];
      float a;
      a = bflo(v.x); ss += a * a; a = bfhi(v.x); ss += a * a; a = bflo(v.y); ss += a * a; a = bfhi(v.y); ss += a * a;
      a = bflo(v.z); ss += a * a; a = bfhi(v.z); ss += a * a; a = bflo(v.w); ss += a * a; a = bfhi(v.w); ss += a * a;
    }
    ss += __shfl_xor(ss, 1);
    if (half == 0) rsq[row] = rsqrtf(ss * (1.f / 128.f) + EPS);
  }
  f32x4 acc[4][4];
#pragma unroll
  for (int i = 0; i < 4; ++i)
#pragma unroll
    for (int j = 0; j < 4; ++j) acc[i][j] = f32x4{0.f, 0.f, 0.f, 0.f};
  gemm_main<128, 128, 2, 2, false, 128>(p.ckv, 160, p.w_ukvT, 128, 128, m0, h * 128, sA, sB, acc);
  if (wn == 0) {
    const float invf = powf(10000.f, -(float)c / 16.f);
    float gn[6];
#pragma unroll
    for (int nt = 0; nt < 6; ++nt) gn[nt] = p.k_norm[nt * 16 + c];
#pragma unroll
    for (int mt = 0; mt < 4; ++mt)
#pragma unroll
      for (int r = 0; r < 4; ++r) {
        const int rl = wm * 64 + mt * 16 + g * 4 + r;
        const int t = m0 + rl; const int b = t >> 11, s = t & 2047;
        const float rs = rsq[rl];
        float kn[4]; float ss = 0.f;
#pragma unroll
        for (int nt = 0; nt < 4; ++nt) { kn[nt] = acc[mt][nt][r] * rs; ss += kn[nt] * kn[nt]; }
        const float pe1 = bf2f(p.ckv[(size_t)t * 160 + 128 + c]), pe2 = bf2f(p.ckv[(size_t)t * 160 + 144 + c]);
        ss += pe1 * pe1 + pe2 * pe2;
        ss = sum16(ss);
        const float rn = rsqrtf(ss * (1.f / 96.f) + EPS);
        u16* dst = p.K + ((size_t)(b * 8 + h) * SEQ + s) * 96;
#pragma unroll
        for (int nt = 0; nt < 4; ++nt) dst[nt * 16 + c] = f2bf(kn[nt] * rn * gn[nt]);
        const float x1 = pe1 * rn * gn[4], x2 = pe2 * rn * gn[5];
        float sn, cs; sincosf((float)s * invf, &sn, &cs);
        dst[64 + c] = f2bf(x1 * cs - x2 * sn);
        dst[80 + c] = f2bf(x2 * cs + x1 * sn);
      }
  } else {
#pragma unroll
    for (int mt = 0; mt < 4; ++mt) {
      const int rl = wm * 64 + mt * 16 + g * 4;
      const int t = m0 + rl; const int b = t >> 11, s = t & 2047;
      float rs[4];
#pragma unroll
      for (int r = 0; r < 4; ++r) rs[r] = rsq[rl + r];
#pragma unroll
      for (int nt = 0; nt < 4; ++nt) {
        const int dcol = nt * 16 + c;
        U2 o; o.x = pack2(acc[mt][nt][0] * rs[0], acc[mt][nt][1] * rs[1]); o.y = pack2(acc[mt][nt][2] * rs[2], acc[mt][nt][3] * rs[3]);
        *(U2*)(p.Vt + ((size_t)(b * 8 + h) * 64 + dcol) * SEQ + s) = o;
      }
    }
  }
}

__device__ __forceinline__ void qkv_items(const Params& p, unsigned char* smem, int bid, int nb) {
  for (int it = bid; it < 1024 + 1024; it += nb) {
    if (it < 1024) { q_tile(p, smem, it >> 3, it & 7); }
    else { int j = it - 1024; kv_tile(p, smem, j >> 3, j & 7); }
  }
}

typedef float f32x2 __attribute__((ext_vector_type(2)));
__device__ __forceinline__ void ph_expert_fp8(const float* src, unsigned char* dst, float* inv_scale, int bid, int nb) {
  const int tid = tidx(), lane = tid & 63, wave = __builtin_amdgcn_readfirstlane(tid >> 6);
  for (int r = bid * 4 + wave; r < 16384; r += nb * 4) {
    const F4* sr = (const F4*)(src + (size_t)r * 1024 + lane * 16);
    F4 v[4]; float mx = 0.f;
#pragma unroll
    for (int i = 0; i < 4; ++i) { v[i] = sr[i]; mx = fmaxf(mx, fmaxf(fmaxf(fabsf(v[i].x), fabsf(v[i].y)), fmaxf(fabsf(v[i].z), fabsf(v[i].w)))); }
#pragma unroll
    for (int o = 32; o > 0; o >>= 1) mx = fmaxf(mx, __shfl_xor(mx, o));
    const float sc = (mx > 0.f) ? 224.f / mx : 1.f;
    if (lane == 0) inv_scale[r] = (mx > 0.f) ? mx * (1.f / 224.f) : 1.f;
    U4 o;
#pragma unroll
    for (int i = 0; i < 4; ++i) {
      int w = __builtin_amdgcn_cvt_pk_fp8_f32(v[i].x * sc, v[i].y * sc, 0, false);
      w = __builtin_amdgcn_cvt_pk_fp8_f32(v[i].z * sc, v[i].w * sc, w, true);
      o[i] = (unsigned)w;
    }
    *(U4*)(dst + (size_t)r * 1024 + lane * 16) = o;
  }
}

__device__ __forceinline__ void phase3(const Params& p, unsigned char* smem, int bid, int nb) {
  constexpr int KS = 104, VS = 72;
  u16* sK = (u16*)smem;
  u16* sV = (u16*)(smem + 13312);
  const int tid = tidx(), lane = tid & 63, wave = __builtin_amdgcn_readfirstlane(tid >> 6), c = lane & 15, g = lane >> 4;
  if (bid >= (nb >> 1)) { for (int ch = bid; ch < 512; ch += nb) hyena_channel(p, smem, ch); }
  for (int it = bid; it < 1024; it += nb) {
    const int qb = it & 15, bh = it >> 4;
    const u16* Qp = p.Q + ((size_t)bh * SEQ + qb * 128 + wave * 32) * 96;
    const u16* Kp = p.K + (size_t)bh * SEQ * 96;
    const u16* Vp = p.Vt + (size_t)bh * 64 * SEQ;
    bf16x8 qf[2][3];
#pragma unroll
    for (int qt = 0; qt < 2; ++qt)
#pragma unroll
      for (int ks = 0; ks < 3; ++ks) qf[qt][ks] = *(const bf16x8*)(Qp + (size_t)(qt * 16 + c) * 96 + ks * 32 + g * 8);
    f32x4 O[4][2];
#pragma unroll
    for (int i = 0; i < 4; ++i)
#pragma unroll
      for (int j = 0; j < 2; ++j) O[i][j] = f32x4{0.f, 0.f, 0.f, 0.f};
    float mrun[2] = {-1e30f, -1e30f}, lrun[2] = {0.f, 0.f};
    U4 rk[3], rv[2];
    const int krot = (blockIdx.x >> 3) & 31;
#pragma unroll
    for (int i = 0; i < 3; ++i) { int ch = tid + i * 256; int row = ch / 12, kc = ch % 12; rk[i] = *(const U4*)(Kp + (size_t)(krot * 64 + row) * 96 + kc * 8); }
#pragma unroll
    for (int i = 0; i < 2; ++i) { int ch = tid + i * 256; int row = ch >> 3, kc = ch & 7; rv[i] = *(const U4*)(Vp + (size_t)row * SEQ + krot * 64 + kc * 8); }
    for (int kt = 0; kt < 32; ++kt) {
      __syncthreads();
#pragma unroll
      for (int i = 0; i < 3; ++i) { int ch = tid + i * 256; int row = ch / 12, kc = ch % 12; *(U4*)(sK + row * KS + kc * 8) = rk[i]; }
#pragma unroll
      for (int i = 0; i < 2; ++i) { int ch = tid + i * 256; int row = ch >> 3, kc = ch & 7; *(U4*)(sV + row * VS + kc * 8) = rv[i]; }
      __syncthreads();
      if (kt + 1 < 32) {
        const int k0 = ((kt + 1 + krot) & 31) * 64;
#pragma unroll
        for (int i = 0; i < 3; ++i) { int ch = tid + i * 256; int row = ch / 12, kc = ch % 12; rk[i] = *(const U4*)(Kp + (size_t)(k0 + row) * 96 + kc * 8); }
#pragma unroll
        for (int i = 0; i < 2; ++i) { int ch = tid + i * 256; int row = ch >> 3, kc = ch & 7; rv[i] = *(const U4*)(Vp + (size_t)row * SEQ + k0 + kc * 8); }
      }
      f32x4 S[4][2];
#pragma unroll
      for (int i = 0; i < 4; ++i)
#pragma unroll
        for (int j = 0; j < 2; ++j) S[i][j] = f32x4{0.f, 0.f, 0.f, 0.f};
#pragma unroll
      for (int ks = 0; ks < 3; ++ks)
#pragma unroll
        for (int k4 = 0; k4 < 4; ++k4) {
          bf16x8 kf = *(const bf16x8*)(sK + (k4 * 16 + c) * KS + ks * 32 + g * 8);
          S[k4][0] = __builtin_amdgcn_mfma_f32_16x16x32_bf16(kf, qf[0][ks], S[k4][0], 0, 0, 0);
          S[k4][1] = __builtin_amdgcn_mfma_f32_16x16x32_bf16(kf, qf[1][ks], S[k4][1], 0, 0, 0);
        }
      bf16x8 pf[2][2];
#pragma unroll
      for (int qt = 0; qt < 2; ++qt) {
        float mx = S[0][qt][0];
#pragma unroll
        for (int k4 = 0; k4 < 4; ++k4)
#pragma unroll
          for (int r = 0; r < 4; ++r) mx = fmaxf(mx, S[k4][qt][r]);
        mx = fmaxf(mx, __shfl_xor(mx, 16)); mx = fmaxf(mx, __shfl_xor(mx, 32));
        float mnew = mrun[qt];
        if (__any(mx > mrun[qt] + 6.f)) {
          mnew = fmaxf(mrun[qt], mx);
          const float alpha = __builtin_amdgcn_exp2f(mrun[qt] - mnew);
          mrun[qt] = mnew;
          lrun[qt] *= alpha;
#pragma unroll
          for (int dt = 0; dt < 4; ++dt)
#pragma unroll
            for (int r = 0; r < 4; ++r) O[dt][qt][r] *= alpha;
        }
        float ls = 0.f;
        float pv[16];
#pragma unroll
        for (int k4 = 0; k4 < 4; ++k4)
#pragma unroll
          for (int r = 0; r < 4; ++r) { float e = __builtin_amdgcn_exp2f(S[k4][qt][r] - mnew); pv[k4 * 4 + r] = e; ls += e; }
        lrun[qt] += ls;
#pragma unroll
        for (int kk = 0; kk < 2; ++kk) {
          typedef __attribute__((ext_vector_type(4))) unsigned u32x4;
          u32x4 w = {pack2(pv[kk * 8 + 0], pv[kk * 8 + 1]), pack2(pv[kk * 8 + 2], pv[kk * 8 + 3]),
                     pack2(pv[kk * 8 + 4], pv[kk * 8 + 5]), pack2(pv[kk * 8 + 6], pv[kk * 8 + 7])};
          pf[qt][kk] = __builtin_bit_cast(bf16x8, w);
        }
      }
#pragma unroll
      for (int kk = 0; kk < 2; ++kk)
#pragma unroll
        for (int dt = 0; dt < 4; ++dt) {
          typedef __attribute__((ext_vector_type(4))) unsigned u32x4;
          const u16* vp = sV + (dt * 16 + c) * VS + kk * 32 + g * 4;
          U2 lo = *(const U2*)vp, hi = *(const U2*)(vp + 16);
          u32x4 w = {lo.x, lo.y, hi.x, hi.y};
          bf16x8 vf = __builtin_bit_cast(bf16x8, w);
          O[dt][0] = __builtin_amdgcn_mfma_f32_16x16x32_bf16(vf, pf[0][kk], O[dt][0], 0, 0, 0);
          O[dt][1] = __builtin_amdgcn_mfma_f32_16x16x32_bf16(vf, pf[1][kk], O[dt][1], 0, 0, 0);
        }
    }
    const int b = bh >> 3, h = bh & 7;
#pragma unroll
    for (int qt = 0; qt < 2; ++qt) {
      float l = lrun[qt];
      l += __shfl_xor(l, 16); l += __shfl_xor(l, 32);
      const float inv = 1.f / l;
      const int s = qb * 128 + wave * 32 + qt * 16 + c;
      u16* dst = p.attn_out + ((size_t)(b * SEQ + s)) * 512 + h * 64;
#pragma unroll
      for (int dt = 0; dt < 4; ++dt) {
        U2 o; o.x = pack2(O[dt][qt][0] * inv, O[dt][qt][1] * inv); o.y = pack2(O[dt][qt][2] * inv, O[dt][qt][3] * inv);
        *(U2*)(dst + dt * 16 + g * 4) = o;
      }
    }
  }
  if (bid < (nb >> 1)) { for (int ch = bid; ch < 512; ch += nb) hyena_channel(p, smem, ch); }
}

__device__ __forceinline__ void phase4(const Params& p, unsigned char* smem, int bid, int nb) {
  const int tid = tidx(), lane = tid & 63, wave = __builtin_amdgcn_readfirstlane(tid >> 6);
  const int wm = wave >> 1, wn = wave & 1, c = lane & 15, g = lane >> 4;
  for (int it = bid; it < 1024; it += nb) {
    const int li_ = (it & 511) >> 3;
    const int m0 = (64 * (it >> 9) + 8 * (it & 7) + (li_ >> 3)) * 128, n0 = (li_ & 7) * 128;
    f32x4 acc[4][4];
#pragma unroll
    for (int i = 0; i < 4; ++i)
#pragma unroll
      for (int j = 0; j < 4; ++j) acc[i][j] = f32x4{0.f, 0.f, 0.f, 0.f};
    gemm_glds<128, 128, 2, 2, true>(p.attn_out, 512, p.w_oaT, 512, 512, m0, n0, smem, acc);
    const u16* gb = p.gates + (size_t)(m0 + wm * 64 + c) * 2048 + n0 + wn * 64 + g * 4;
#pragma unroll
    for (int mt = 0; mt < 4; ++mt)
#pragma unroll
      for (int nt = 0; nt < 4; ++nt) {
        const U2 ga = *(const U2*)(gb + (mt * 16) * 2048 + nt * 16);
        const U2 gh = *(const U2*)(gb + (mt * 16) * 2048 + nt * 16 + 1024);
        acc[mt][nt][0] *= bflo(ga.x) * __frcp_rn(bflo(gh.x));
        acc[mt][nt][1] *= bfhi(ga.x) * __frcp_rn(bfhi(gh.x));
        acc[mt][nt][2] *= bflo(ga.y) * __frcp_rn(bflo(gh.y));
        acc[mt][nt][3] *= bfhi(ga.y) * __frcp_rn(bfhi(gh.y));
      }
    gemm_glds_at<true>(p.yhT, T_TOK, p.w_ohT, 512, 512, m0, n0, smem, acc);
    u16* mb = p.merged + (size_t)(m0 + wm * 64 + c) * 1024 + n0 + wn * 64 + g * 4;
#pragma unroll
    for (int mt = 0; mt < 4; ++mt)
#pragma unroll
      for (int nt = 0; nt < 4; ++nt) {
        const U2 gh = *(const U2*)(gb + (mt * 16) * 2048 + nt * 16 + 1024);
        U2 o;
        o.x = pack2(acc[mt][nt][0] * bflo(gh.x), acc[mt][nt][1] * bfhi(gh.x));
        o.y = pack2(acc[mt][nt][2] * bflo(gh.y), acc[mt][nt][3] * bfhi(gh.y));
        *(U2*)(mb + (mt * 16) * 1024 + nt * 16) = o;
      }
  }
}

__device__ __forceinline__ void phase5(const Params& p, unsigned char* smem, int bid, int nb) {
  const int tid = tidx(), lane = tid & 63, wave = __builtin_amdgcn_readfirstlane(tid >> 6);
  const int wm = wave >> 1, wn = wave & 1, c = lane & 15, g = lane >> 4;
  for (int it = bid; it < 1024; it += nb) {
    const int li_ = (it & 511) >> 3;
    const int m0 = (64 * (it >> 9) + 8 * (it & 7) + (li_ >> 3)) * 128, n0 = (li_ & 7) * 128;
    f32x4 acc[4][4];
#pragma unroll
    for (int i = 0; i < 4; ++i)
#pragma unroll
      for (int j = 0; j < 4; ++j) acc[i][j] = f32x4{0.f, 0.f, 0.f, 0.f};
    gemm_glds<128, 128, 2, 2, true>(p.merged, 1024, p.w_outT, 1024, 1024, m0, n0, smem, acc);
#pragma unroll
    for (int mt = 0; mt < 4; ++mt) {
      const int t = m0 + wm * 64 + mt * 16 + c;
      float ss = 0.f;
#pragma unroll
      for (int nt = 0; nt < 4; ++nt) {
        const int n = n0 + wn * 64 + nt * 16 + g * 4;
        const F4 xv = *(const F4*)(p.x + (size_t)t * 1024 + n);
        const F4 gn = *(const F4*)(p.ffn_norm + n);
        F4 h1;
        h1.x = xv.x + acc[mt][nt][0]; h1.y = xv.y + acc[mt][nt][1]; h1.z = xv.z + acc[mt][nt][2]; h1.w = xv.w + acc[mt][nt][3];
        *(F4*)(p.out + (size_t)t * 1024 + n) = h1;
        U2 o; o.x = pack2(h1.x * gn.x, h1.y * gn.y); o.y = pack2(h1.z * gn.z, h1.w * gn.w);
        *(U2*)(p.hb + (size_t)t * 1024 + n) = o;
        ss += h1.x * h1.x + h1.y * h1.y + h1.z * h1.z + h1.w * h1.w;
      }
      ss += __shfl_xor(ss, 16); ss += __shfl_xor(ss, 32);
      if (g == 0) p.ssq2[t * 16 + (n0 >> 6) + wn] = ss;
    }
  }
}

#define KEY_INSERT(xk)                                                               \
  {                                                                                  \
    float x_ = (xk);                                                                 \
    _Pragma("unroll") for (int k_ = 0; k_ < 16; ++k_) {                              \
      const float hi_ = fmaxf(tv[k_], x_); x_ = fminf(tv[k_], x_); tv[k_] = hi_;    \
    }                                                                                \
  }

__device__ __forceinline__ void phase6(const Params& p, unsigned char* smem, int bid, int nb) {
  float* sc = (float*)smem;
  float* rsl = (float*)(smem + OFF_RS);
  const int tid = tidx(), lane = tid & 63, wave = __builtin_amdgcn_readfirstlane(tid >> 6), c = lane & 15, g = lane >> 4;
  const int wm = wave >> 1, wn = wave & 1;
  if (bid >= (nb >> 1)) { ph_expert_fp8(p.eu, p.eu8, p.eus, bid, nb); ph_expert_fp8(p.ev, p.ev8, p.evs, bid, nb); }
  for (int it = bid; it < 2048; it += nb) {
    const int li_ = (it & 511) >> 3;
    const int hs = li_ & 15, m0 = (32 * (it >> 9) + 4 * (it & 7) + (li_ >> 4)) * 128;
    __syncthreads();
    if (tid < 128) {
      const float* sq = p.ssq2 + (size_t)(m0 + tid) * 16;
      float s = 0.f;
#pragma unroll
      for (int i = 0; i < 16; ++i) s += sq[i];
      rsl[tid] = rsqrtf(s * (1.f / 1024.f) + EPS);
    }
    f32x4 acc[4][4];
#pragma unroll
    for (int i = 0; i < 4; ++i)
#pragma unroll
      for (int j = 0; j < 4; ++j) acc[i][j] = f32x4{0.f, 0.f, 0.f, 0.f};
    gemm_glds<128, 128, 2, 2>(p.hb, 1024, p.wcT, 1024, 1024, m0, hs * 128, smem, acc);
#pragma unroll
    for (int mt = 0; mt < 4; ++mt)
#pragma unroll
      for (int r = 0; r < 4; ++r) {
        const int rl = wm * 64 + mt * 16 + g * 4 + r;
        const float rstd = rsl[rl];
#pragma unroll
        for (int nt = 0; nt < 4; ++nt) {
          const int col = wn * 64 + nt * 16 + c;
          const unsigned kb = (__float_as_uint(acc[mt][nt][r] * rstd) & 0xffffff80u) | (unsigned)col;
          sc[rl * 129 + col] = __uint_as_float(kb);
        }
      }
    __syncthreads();
    float tv[16];
    const int row = tid & 127;
    float* seg = sc + row * 129 + (tid >> 7) * 64;
#pragma unroll
    for (int k = 0; k < 16; ++k) tv[k] = -3.0e38f;
#pragma unroll 8
    for (int j = 0; j < 64; ++j) { KEY_INSERT(seg[j]) }
    if (tid >= 128) {
#pragma unroll
      for (int k = 0; k < 16; ++k) seg[k] = tv[k];
    }
    __syncthreads();
    if (tid < 128) {
#pragma unroll
      for (int k = 0; k < 16; ++k) tv[k] = fmaxf(tv[k], seg[64 + 15 - k]);
#pragma unroll
      for (int st = 8; st > 0; st >>= 1)
#pragma unroll
        for (int k = 0; k < 16; ++k)
          if ((k & st) == 0) { const float hi = fmaxf(tv[k], tv[k + st]), lo = fminf(tv[k], tv[k + st]); tv[k] = hi; tv[k + st] = lo; }
      F4* dst = (F4*)(p.tk + ((size_t)(m0 + row) * 16 + hs) * 16);
      dst[0] = F4{tv[0], tv[1], tv[2], tv[3]}; dst[1] = F4{tv[4], tv[5], tv[6], tv[7]};
      dst[2] = F4{tv[8], tv[9], tv[10], tv[11]}; dst[3] = F4{tv[12], tv[13], tv[14], tv[15]};
    }
  }
  if (bid < (nb >> 1)) { ph_expert_fp8(p.eu, p.eu8, p.eus, bid, nb); ph_expert_fp8(p.ev, p.ev8, p.evs, bid, nb); }
}

__device__ __forceinline__ void combine_task(const Params& p, int task, int* oi, float* og) {
  const float* s1 = p.tk + (size_t)task * 32; const float* s2 = s1 + 16;
  float v1[16], v2[16];
#pragma unroll
  for (int k4 = 0; k4 < 4; ++k4) {
    const F4 a = ((const F4*)s1)[k4], b = ((const F4*)s2)[k4];
    v1[4 * k4] = a.x; v1[4 * k4 + 1] = a.y; v1[4 * k4 + 2] = a.z; v1[4 * k4 + 3] = a.w;
    v2[4 * k4] = b.x; v2[4 * k4 + 1] = b.y; v2[4 * k4 + 2] = b.z; v2[4 * k4 + 3] = b.w;
  }
  float tv[16];
#pragma unroll
  for (int k = 0; k < 16; ++k) tv[k] = -3.0e38f;
#pragma unroll
  for (int a = 0; a < 16; ++a)
#pragma unroll
    for (int b = 0; b < 16; ++b)
      if ((a + 1) * (b + 1) <= 16) {
        const unsigned kb = (__float_as_uint(v1[a] + v2[b]) & 0xffffff00u) | (unsigned)(a * 16 + b);
        KEY_INSERT(__uint_as_float(kb))
      }
  float es[16]; float sum = 0.f;
#pragma unroll
  for (int k = 0; k < 16; ++k) { es[k] = __expf(tv[k] - tv[0]); sum += es[k]; }
  const float inv = 1.f / sum;
#pragma unroll
  for (int k = 0; k < 16; ++k) {
    const unsigned ab = __float_as_uint(tv[k]) & 0xffu;
    const int a = ab >> 4, b = ab & 15;
    oi[k] = (int)(__float_as_uint(s1[a]) & 127u) * 128 + (int)(__float_as_uint(s2[b]) & 127u);
    og[k] = es[k] * inv;
  }
}
__device__ __forceinline__ void phase6b(const Params& p, int bid, int nb) {
  for (int task = bid * 256 + tidx(); task < T_TOK * 8; task += nb * 256)
    combine_task(p, task, p.sel_idx + (size_t)task * 16, p.sel_g + (size_t)task * 16);
}

__device__ __forceinline__ void unpack8(U4 v, float* f) {
  f[0] = bflo(v.x); f[1] = bfhi(v.x); f[2] = bflo(v.y); f[3] = bfhi(v.y);
  f[4] = bflo(v.z); f[5] = bfhi(v.z); f[6] = bflo(v.w); f[7] = bfhi(v.w);
}

__device__ __forceinline__ float dot16_fp8(U4 r, const float* hv) {
  f32x2 s2 = {0.f, 0.f};
#pragma unroll
  for (int k = 0; k < 4; ++k) {
    const f32x2 a = __builtin_amdgcn_cvt_pk_f32_fp8((int)r[k], false), b = __builtin_amdgcn_cvt_pk_f32_fp8((int)r[k], true);
    const f32x2 h0 = {hv[4 * k], hv[4 * k + 1]}, h1 = {hv[4 * k + 2], hv[4 * k + 3]};
    s2 = __builtin_elementwise_fma(a, h0, s2);
    s2 = __builtin_elementwise_fma(b, h1, s2);
  }
  return s2.x + s2.y;
}
__device__ __forceinline__ void axpy16_fp8(U4 r, float w, float* acc) {
  const f32x2 w2 = {w, w};
#pragma unroll
  for (int k = 0; k < 4; ++k) {
    const f32x2 a = __builtin_amdgcn_cvt_pk_f32_fp8((int)r[k], false), b = __builtin_amdgcn_cvt_pk_f32_fp8((int)r[k], true);
    f32x2 c0 = {acc[4 * k], acc[4 * k + 1]}, c1 = {acc[4 * k + 2], acc[4 * k + 3]};
    c0 = __builtin_elementwise_fma(w2, a, c0);
    c1 = __builtin_elementwise_fma(w2, b, c1);
    acc[4 * k] = c0.x; acc[4 * k + 1] = c0.y; acc[4 * k + 2] = c1.x; acc[4 * k + 3] = c1.y;
  }
}
#define P7_LOAD(dst, tab, bidx)                                                               \
  _Pragma("unroll") for (int j_ = 0; j_ < 8; ++j_) {                                          \
    const int e_ = (bidx) * 8 + j_;                                                           \
    const int id_ = __builtin_amdgcn_readlane((e_ < 64) ? id0 : id1, e_ & 63);                \
    dst[j_] = *(const U4*)((tab) + (size_t)id_ * 1024 + lane * 16);                           \
  }
__device__ __forceinline__ float swapsum32(float a, float b) {
  const auto r = __builtin_amdgcn_permlane32_swap(__float_as_uint(a), __float_as_uint(b), false, false);
  return __uint_as_float(r[0]) + __uint_as_float(r[1]);
}
__device__ __forceinline__ float swapsum16(float a, float b) {
  const auto r = __builtin_amdgcn_permlane16_swap(__float_as_uint(a), __float_as_uint(b), false, false);
  return __uint_as_float(r[0]) + __uint_as_float(r[1]);
}
template <int CTRL>
__device__ __forceinline__ float dppf(float v) { return __int_as_float(__builtin_amdgcn_update_dpp(0, __float_as_int(v), CTRL, 0xF, 0xF, true)); }
#define P7_ACT(src, bidx)                                                                     \
  {                                                                                           \
    float d_[8];                                                                              \
    _Pragma("unroll") for (int j_ = 0; j_ < 8; ++j_) d_[j_] = dot16_fp8(src[j_], hv);         \
    const float r10_ = swapsum32(d_[0], d_[1]), r11_ = swapsum32(d_[2], d_[3]);               \
    const float r12_ = swapsum32(d_[4], d_[5]), r13_ = swapsum32(d_[6], d_[7]);               \
    const float r20_ = swapsum16(r10_, r11_), r21_ = swapsum16(r12_, r13_);                   \
    const float keep_ = (lane & 8) ? r21_ : r20_;                                             \
    const float send_ = (lane & 8) ? r20_ : r21_;                                             \
    float r3_ = keep_ + dppf<0x128>(send_);                   \
    r3_ += dppf<0x141>(r3_);                                  \
    r3_ += dppf<0xB1>(r3_);                                            \
    r3_ += dppf<0x4E>(r3_);                                            \
    if ((lane & 7) == 0) wl[(bidx) * 8 + jl] = r3_;                                           \
  }
#define P7_ACC(src, bidx)                                                                     \
  {                                                                                           \
    const F4 wa_ = *(const F4*)(wl + (bidx) * 8), wb_ = *(const F4*)(wl + (bidx) * 8 + 4);    \
    axpy16_fp8(src[0], wa_.x, acc); axpy16_fp8(src[1], wa_.y, acc);                           \
    axpy16_fp8(src[2], wa_.z, acc); axpy16_fp8(src[3], wa_.w, acc);                           \
    axpy16_fp8(src[4], wb_.x, acc); axpy16_fp8(src[5], wb_.y, acc);                           \
    axpy16_fp8(src[6], wb_.z, acc); axpy16_fp8(src[7], wb_.w, acc);                           \
  }

__device__ __forceinline__ void sort128(int& r0, int& r1, int lane) {
#pragma unroll
  for (int k = 2; k <= 128; k <<= 1) {
#pragma unroll
    for (int j = k >> 1; j > 0; j >>= 1) {
      if (j == 64) { const int lo = min(r0, r1), hi = max(r0, r1); r0 = lo; r1 = hi; }
      else {
        const bool lower = (lane & j) == 0;
        { const int pv = __shfl_xor(r0, j); const bool asc = (k == 128) || ((lane & k) == 0); r0 = (lower == asc) ? min(r0, pv) : max(r0, pv); }
        { const int pv = __shfl_xor(r1, j); const bool asc = (k == 128) || (((64 + lane) & k) == 0); r1 = (lower == asc) ? min(r1, pv) : max(r1, pv); }
      }
    }
  }
}

__device__ __forceinline__ void phase7(const Params& p, unsigned char* smem, int bid, int nb, float* outp, bool fused) {
  const int tid = tidx(), lane = tid & 63, wave = __builtin_amdgcn_readfirstlane(tid >> 6);
  float* wl0 = (float*)smem + wave * 2048;
  int* sidl0 = (int*)smem + 8192 + wave * 2048;
  const int jl = ((lane >> 3) & 1) * 4 + ((lane >> 4) & 1) * 2 + ((lane >> 5) & 1);
  const int tstep = nb * 4;
  int* selI = sidl0 + 1024; float* selG = wl0 + 1024;
  if (fused) {
    const int t = bid * 4 + wave + (lane >> 3) * tstep;
    if (t < T_TOK) combine_task(p, t * 8 + (lane & 7), selI + lane * 16, selG + lane * 16);
  }
  {
    int k = 0;
#pragma unroll 1
    for (int t = bid * 4 + wave; t < T_TOK; t += tstep, ++k) {
      float* wl = wl0 + k * 128;
      const U4* hr = (const U4*)(p.hb + (size_t)t * 1024 + lane * 16);
      float hv[16];
      unpack8(hr[0], hv); unpack8(hr[1], hv + 8);
      float s = 0.f;
#pragma unroll
      for (int i = 0; i < 16; ++i) s += p.ssq2[(size_t)t * 16 + i];
      const float rstd = rsqrtf(s * (1.f / 1024.f) + EPS);
      int k0 = ((fused ? selI[k * 128 + lane] : p.sel_idx[(size_t)t * 128 + lane]) << 7) | lane;
      int k1 = ((fused ? selI[k * 128 + 64 + lane] : p.sel_idx[(size_t)t * 128 + 64 + lane]) << 7) | (64 + lane);
      sort128(k0, k1, lane);
      const int id0 = k0 >> 7, id1 = k1 >> 7;
      sidl0[k * 128 + lane] = id0; sidl0[k * 128 + 64 + lane] = id1;
      const float us0 = p.eus[id0] * rstd, us1 = p.eus[id1] * rstd;
      const float gv0 = (fused ? selG[k * 128 + (k0 & 127)] : p.sel_g[(size_t)t * 128 + (k0 & 127)]) * p.evs[id0];
      const float gv1 = (fused ? selG[k * 128 + (k1 & 127)] : p.sel_g[(size_t)t * 128 + (k1 & 127)]) * p.evs[id1];
      U4 ba[8], bb[8], bc[8];
      P7_LOAD(ba, p.eu8, 0)
      P7_LOAD(bb, p.eu8, 1)
#pragma unroll 1
      for (int b = 0; b < 15; b += 3) {
        const int b3 = (b + 3 < 15) ? b + 3 : 15, b4 = (b + 4 < 15) ? b + 4 : 15;
        P7_LOAD(bc, p.eu8, b + 2)
        P7_ACT(ba, b)
        P7_LOAD(ba, p.eu8, b3)
        P7_ACT(bb, b + 1)
        P7_LOAD(bb, p.eu8, b4)
        P7_ACT(bc, b + 2)
      }
      P7_ACT(ba, 15)
      {
        const float x0 = wl[lane] * us0, x1 = wl[64 + lane] * us1;
        wl[lane] = gv0 * 0.5f * x0 * (1.f + erff(x0 * 0.70710678118654752f));
        wl[64 + lane] = gv1 * 0.5f * x1 * (1.f + erff(x1 * 0.70710678118654752f));
      }
    }
  }
#define P7B_LOAD(dst, bidx)                                                                    \
  _Pragma("unroll") for (int j_ = 0; j_ < 32; ++j_) {                                          \
    const int e_ = (bidx) * 32 + j_;                                                           \
    const int id_ = __builtin_amdgcn_readlane(((bidx) < 2) ? id0 : id1, e_ & 63);              \
    dst[j_] = *(const unsigned*)(vb + (size_t)id_ * 1024);                                     \
  }
#define P7B_ACC(src, bidx)                                                                     \
  _Pragma("unroll") for (int j4_ = 0; j4_ < 8; ++j4_) {                                        \
    const F4 w4_ = *(const F4*)(wl + (bidx) * 32 + j4_ * 4);                                   \
    _Pragma("unroll") for (int jj_ = 0; jj_ < 4; ++jj_) {                                      \
      const float ws_ = w4_[jj_];                                                              \
      const f32x2 w2_ = {ws_, ws_};                                                            \
      const int r_ = (int)src[j4_ * 4 + jj_];                                                  \
      a01 = __builtin_elementwise_fma(w2_, __builtin_amdgcn_cvt_pk_f32_fp8(r_, false), a01);   \
      a23 = __builtin_elementwise_fma(w2_, __builtin_amdgcn_cvt_pk_f32_fp8(r_, true), a23);    \
    }                                                                                          \
  }
#pragma unroll 1
  for (int q = 0; q < 4; ++q) {
    const unsigned char* vb = p.ev8 + q * 256 + lane * 4;
    int k = 0;
#pragma unroll 1
    for (int t = bid * 4 + wave; t < T_TOK; t += tstep, ++k) {
      const float* wl = wl0 + k * 128;
      const int id0 = sidl0[k * 128 + lane], id1 = sidl0[k * 128 + 64 + lane];
      unsigned ra[32], rb[32], rc[32];
      f32x2 a01 = {0.f, 0.f}, a23 = {0.f, 0.f};
      P7B_LOAD(ra, 0)
      P7B_LOAD(rb, 1)
      P7B_LOAD(rc, 2)
      P7B_ACC(ra, 0)
      P7B_LOAD(ra, 3)
      P7B_ACC(rb, 1)
      P7B_ACC(rc, 2)
      P7B_ACC(ra, 3)
      F4* o = (F4*)(outp + (size_t)t * 1024 + q * 256 + lane * 4);
      F4 v = *o;
      v.x += a01.x; v.y += a01.y; v.z += a23.x; v.w += a23.y;
      *o = v;
    }
  }
#undef P7B_LOAD
#undef P7B_ACC
}

__device__ __forceinline__ void run_phase(int ph, const Params& p, unsigned char* smem, int bid, int nb) {
#ifdef ONLY_PHASE
  if (ph != ONLY_PHASE) return;
#endif
  switch (ph) {
    case 0: phase0(p, smem, lbid(), nb); break;
    case 1: phase1<0>(p, smem, lbid(), nb); break;
    case 2: phase1<1>(p, smem, lbid(), nb); break;
    case 3: phase3(p, smem, lbid(), nb); break;
    case 4: phase4(p, smem, lbid(), nb); break;
    case 5: phase5(p, smem, lbid(), nb); break;
    case 6: phase6(p, smem, lbid(), nb); break;
    default: phase7(p, smem, lbid(), nb, p.out, false); break;
  }
}

__global__ void __launch_bounds__(256, 2) mega_kernel(Params p) {
  __shared__ __attribute__((aligned(16))) unsigned char smem[SMEM_BYTES];
  __shared__ U4 xb_words;
  cg::grid_group grid = cg::this_grid();
  const int bid = blockIdx.x, nb = gridDim.x;
  if (tidx() == 0) xb_words = U4{0u, 0u, 0u, 0u};
  __syncthreads();
  (void)xcd_barrier_post(p.bar, (volatile LAS unsigned*)&xb_words);
#define XBAR() do { XcdBarrier xb_; xb_.bar = p.bar; xb_.x = xb_xcc_id(); xb_.st = (volatile LAS unsigned*)&xb_words; xcd_barrier(xb_); } while (0)
#ifdef ONLY_PHASE
  run_phase(ONLY_PHASE, p, smem, bid, nb);
  grid.sync();
  XBAR();
#else
#ifndef DUP_PHASE
#define DUP_PHASE -1
#endif
#define DUP(k, call) if (DUP_PHASE == k) { call; XBAR(); }
  phase0(p, smem, lbid(), nb);
  if (p.use_cg) grid.sync();
  XBAR();
  DUP(0, phase0(p, smem, lbid(), nb))
  phase1<0>(p, smem, lbid(), nb); XBAR();
  DUP(1, phase1<1>(p, smem, lbid(), nb))
  phase1<1>(p, smem, lbid(), nb); XBAR();
  DUP(3, phase3(p, smem, lbid(), nb))
  phase3(p, smem, lbid(), nb); XBAR();
  DUP(4, phase4(p, smem, lbid(), nb))
  phase4(p, smem, lbid(), nb); XBAR();
  DUP(5, phase5(p, smem, lbid(), nb))
  phase5(p, smem, lbid(), nb); XBAR();
  DUP(6, phase6(p, smem, lbid(), nb))
  phase6(p, smem, lbid(), nb); XBAR();
  const bool fuse6b = (nb * 32 >= T_TOK);
  if (!fuse6b) { phase6b(p, lbid(), nb); XBAR(); }
  DUP(7, phase7(p, smem, lbid(), nb, (float*)p.K, fuse6b))
  phase7(p, smem, lbid(), nb, p.out, fuse6b);
#endif
}

#if MULTI_LAUNCH
__global__ void __launch_bounds__(256, 2) phase_kernel(Params p, int ph) {
  __shared__ __attribute__((aligned(16))) unsigned char smem[SMEM_BYTES];
  run_phase(ph, p, smem, blockIdx.x, gridDim.x);
}
#endif

extern "C" void kernel_launch(void* const* d_in, const int* in_sizes, int n_in, void* d_out, int out_size, void* d_ws,
                              size_t ws_size, hipStream_t stream) {
  (void)in_sizes; (void)n_in; (void)out_size;
  Params p{};
  const float** fp = (const float**)&p;
  for (int i = 0; i < 31; ++i) fp[i] = (const float*)d_in[i];
  p.out = (float*)d_out;
  unsigned char* w = (unsigned char*)d_ws;
  const size_t MB = 1024 * 1024;
  size_t off = 0;
  unsigned char* R1 = w + off; off += 64 * MB;
  unsigned char* R2 = w + off; off += 48 * MB;
  unsigned char* R3 = w + off; off += 32 * MB;
  unsigned char* R4 = w + off; off += 24 * MB;
  unsigned char* R5 = w + off; off += 16 * MB;
  unsigned char* R6 = w + off; off += 16 * MB;
  unsigned char* R7 = w + off; off += 24 * MB;
  auto take = [&](size_t bytes) { unsigned char* q = w + off; off += (bytes + 255) & ~(size_t)255; return q; };
  p.gates = (u16*)R1; p.eub = (u16*)R1; p.evb = (u16*)(R1 + 32 * MB); p.eu8 = R1; p.ev8 = R1 + 16 * MB;
  p.uT = (u16*)R2; p.merged = (u16*)R4; p.sel_idx = (int*)(R2 + 32 * MB); p.sel_g = (float*)(R2 + 40 * MB);
  p.xb = (u16*)R3; p.Q = (u16*)R7; p.hb = (u16*)R3;
  p.K = (u16*)R4; p.Vt = (u16*)R5;
  p.cq = (u16*)R6; p.ckv = (u16*)(R6 + 8 * MB); p.attn_out = (u16*)R6; p.tk = (float*)R6;
  p.yhT = (u16*)R3;
  p.w_inT = (u16*)take((size_t)4096 * 1024 * 2);
  p.w_uqT = (u16*)take((size_t)768 * 256 * 2);
  p.w_ukvT = (u16*)take((size_t)1024 * 128 * 2);
  p.w_oaT = (u16*)take((size_t)1024 * 512 * 2);
  p.w_ohT = (u16*)take((size_t)1024 * 512 * 2);
  p.w_outT = (u16*)take((size_t)1024 * 1024 * 2);
  p.wqb = (u16*)take((size_t)1024 * 2048 * 2);
  p.keysb = (u16*)take((size_t)2 * 8 * 128 * 128 * 2);
  p.wcT = (u16*)take((size_t)2048 * 1024 * 2);
  p.h3 = (float*)take((size_t)2048 * 64 * 4);
  p.rstd1 = (float*)take((size_t)T_TOK * 4);
  p.ssq2 = (float*)take((size_t)T_TOK * 16 * 4);
  p.bar = (unsigned*)take((size_t)XCD_BAR_WORDS * 4);
  p.eus = (float*)take((size_t)16384 * 4);
  p.filt = (u16*)take((size_t)1024 * 2048 * 2);
  p.use_cg = 0; p.pad_ = 0;
  p.evs = (float*)take((size_t)16384 * 4);
  if (off > ws_size) { fprintf(stderr, "workspace too small: need %zu have %zu\n", off, ws_size); return; }

  (void)hipMemsetAsync(p.bar, 0, (size_t)XCD_BAR_WORDS * 4, stream);
#if MULTI_LAUNCH
  for (int ph = 0; ph < 8; ++ph) phase_kernel<<<dim3(512), dim3(256), 0, stream>>>(p, ph);
#else
  static int grid_blocks = 0;
  if (!grid_blocks) {
    int dev = 0, cus = 0, per_cu = 0;
    (void)hipGetDevice(&dev);
    (void)hipDeviceGetAttribute(&cus, hipDeviceAttributeMultiprocessorCount, dev);
    (void)hipOccupancyMaxActiveBlocksPerMultiprocessor(&per_cu, mega_kernel, 256, 0);
    if (per_cu > 2) per_cu = 2;
    if (per_cu < 1) per_cu = 1;
    grid_blocks = cus * per_cu;
  }
  void* args[] = {&p};
  hipError_t e = hipLaunchCooperativeKernel((void*)mega_kernel, dim3(grid_blocks), dim3(256), args, 0, stream);
  if (e != hipSuccess) fprintf(stderr, "cooperative launch failed: %s (grid %d)\n", hipGetErrorString(e), grid_blocks);
#endif
}
```

```cpp
#include <hip/hip_runtime.h>
#include <hip/hip_cooperative_groups.h>
#include <cstdio>
#include <cstdint>
namespace cg = cooperative_groups;

#ifndef MULTI_LAUNCH
#define MULTI_LAUNCH 0
#endif

typedef unsigned short u16;
typedef __attribute__((ext_vector_type(8))) short bf16x8;
typedef __attribute__((ext_vector_type(4))) float f32x4;
typedef __attribute__((ext_vector_type(16))) float f32x16;
typedef __attribute__((ext_vector_type(4))) unsigned U4;
typedef __attribute__((ext_vector_type(2))) unsigned U2;
typedef __attribute__((ext_vector_type(4))) float F4;

constexpr int T_TOK = 16384;
constexpr int SEQ = 2048;
constexpr float EPS = 1e-6f;
constexpr int SMEM_BYTES = 72192;
constexpr int OFF_SB = 34816;
constexpr int OFF_RS = 71680;
constexpr int ZS = 2248;

struct Params {
  const float *x, *attn_norm, *w_in, *b_gate, *q_a_norm, *w_uq, *kv_a_norm, *w_ukv, *q_norm, *k_norm, *w_o_attn,
      *conv_w, *conv_b, *fw1, *fb1, *fw2, *fb2, *fw3, *fb3, *fw4, *fb4, *ffreq, *hbias, *w_o_hyena, *w_out, *ffn_norm,
      *peer_wq, *keys1, *keys2, *eu, *ev;
  float* out;
  u16 *xb, *w_inT, *w_uqT, *w_ukvT, *w_oaT, *w_ohT, *w_outT, *wqb, *keysb, *wcT, *eub, *evb;
  u16 *cq, *ckv, *uT, *gates, *Q, *K, *Vt, *attn_out, *yhT, *merged, *hb;
  float *h3, *rstd1, *ssq2, *sel_g;
  int* sel_idx;
  unsigned* bar;
  unsigned char *eu8, *ev8;
  float *eus, *evs;
  u16* filt;
  float* tk;
  int use_cg; int pad_;
};

typedef __bf16 bf16x2_t __attribute__((ext_vector_type(2)));
typedef float f32x2_t __attribute__((ext_vector_type(2)));
__device__ __forceinline__ unsigned pack2(float a, float b) {
  const f32x2_t v = {a, b};
  return __builtin_bit_cast(unsigned, __builtin_convertvector(v, bf16x2_t));
}
__device__ __forceinline__ u16 f2bf(float f) { return (u16)(pack2(f, 0.f) & 0xffffu); }
__device__ __forceinline__ int tidx() { int t = threadIdx.x; asm volatile("" : "+v"(t)); return t; }
__device__ __forceinline__ int lbid() { int b = blockIdx.x; asm volatile("" : "+s"(b)); return b; }
__device__ __forceinline__ float bf2f(u16 h) { return __uint_as_float(((unsigned)h) << 16); }
__device__ __forceinline__ float bflo(unsigned w) { return __uint_as_float(w << 16); }
__device__ __forceinline__ float bfhi(unsigned w) { return __uint_as_float(w & 0xffff0000u); }
__device__ __forceinline__ float wave_sum(float v) {
#pragma unroll
  for (int o = 32; o > 0; o >>= 1) v += __shfl_xor(v, o);
  return v;
}
__device__ __forceinline__ float sum16(float v) {
  v += __shfl_xor(v, 1); v += __shfl_xor(v, 2); v += __shfl_xor(v, 4); v += __shfl_xor(v, 8);
  return v;
}


#define XB_TMO      128
#define XB_XCNT(j)  (256  + 64 * (j))
#define XB_XSUB(j)  (1280 + 64 * (j))
#define XB_XGEN(j)  (2304 + 64 * (j))
#define XB_TOP      3328
#define XB_TOPGEN   3392
#define XCD_BAR_WORDS 3456
#define XB_SPIN_CAP (1u << 22)
#define LAS __attribute__((address_space(3)))
__device__ __forceinline__ unsigned xb_ld(unsigned* p)              { return __hip_atomic_load(p, __ATOMIC_RELAXED, __HIP_MEMORY_SCOPE_AGENT); }
__device__ __forceinline__ unsigned xb_add(unsigned* p, unsigned v) { return __hip_atomic_fetch_add(p, v, __ATOMIC_RELAXED, __HIP_MEMORY_SCOPE_AGENT); }
__device__ __forceinline__ unsigned xb_xcc_id() { return (unsigned)__builtin_amdgcn_s_getreg((3 << 11) | 20) & 0xFu; }
#define XB_SPIN(cond, bar) do { unsigned _sp = 0; while (cond) { __builtin_amdgcn_s_sleep(1); \
    if ((++_sp & 255u) == 0u) { if (xb_ld(&(bar)[XB_TMO])) break; if (_sp > XB_SPIN_CAP) { atomicAdd(&(bar)[XB_TMO], 1u); break; } } } } while (0)
struct XcdBarrier { unsigned* bar; unsigned x; volatile LAS unsigned* st; };
__device__ __forceinline__ XcdBarrier xcd_barrier_post(unsigned* bar, volatile LAS unsigned* st) {
  XcdBarrier b; b.bar = bar; b.x = xb_xcc_id(); b.st = st;
  if (threadIdx.x == 0) (void)xb_add(&bar[XB_XCNT(b.x)], 1u);
  return b;
}
__device__ __forceinline__ void xcd_barrier_complete(unsigned* bar, unsigned x, unsigned& nloc, unsigned& nx) {
  const unsigned G = gridDim.x * gridDim.y * gridDim.z;
  unsigned sum, cnt, mine, sp = 0u;
  for (;;) {
    sum = 0u; cnt = 0u; mine = 0u;
#pragma unroll
    for (unsigned j = 0; j < 16; ++j) { const unsigned c = xb_ld(&bar[XB_XCNT(j)]); sum += c; cnt += (c > 0u) ? 1u : 0u; mine = (j == x) ? c : mine; }
    if (sum == G) break;
    __builtin_amdgcn_s_sleep(1);
    if ((++sp & 255u) == 0u) { if (xb_ld(&bar[XB_TMO])) break; if (sp > XB_SPIN_CAP) { atomicAdd(&bar[XB_TMO], 1u); break; } }
  }
  nloc = mine > 0u ? mine : 1u; nx = cnt > 0u ? cnt : 1u;
}
__device__ __forceinline__ void xcd_barrier(const XcdBarrier& b) {
  asm volatile("s_waitcnt vmcnt(0)" ::: "memory");
  __syncthreads();
  if (threadIdx.x == 0) {
    unsigned* bar = b.bar;
    __builtin_amdgcn_s_waitcnt(0);
    unsigned nloc = b.st[0], nx = b.st[1];
    if (nloc == 0u) { xcd_barrier_complete(bar, b.x, nloc, nx); b.st[0] = nloc; b.st[1] = nx; }
    const unsigned old = xb_add(&bar[XB_XSUB(b.x)], 1u);
    const unsigned gen = old / nloc;
    if (old + 1u == (gen + 1u) * nloc) {
      __builtin_amdgcn_fence(__ATOMIC_RELEASE, "agent");
      asm volatile("s_waitcnt vmcnt(0)" ::: "memory");
      const unsigned og = xb_add(&bar[XB_TOP], 1u);
      const unsigned tg = og / nx;
      if (og + 1u == (tg + 1u) * nx) xb_add(&bar[XB_TOPGEN], 1u);
      else XB_SPIN(xb_ld(&bar[XB_TOPGEN]) == tg, bar);
      __builtin_amdgcn_fence(__ATOMIC_ACQUIRE, "agent");
      xb_add(&bar[XB_XGEN(b.x)], 1u);
      asm volatile("s_waitcnt vmcnt(0)" ::: "memory");
    } else {
      XB_SPIN(xb_ld(&bar[XB_XGEN(b.x)]) == gen, bar);
      __builtin_amdgcn_fence(__ATOMIC_ACQUIRE, "agent");
      asm volatile("s_waitcnt vmcnt(0)" ::: "memory");
    }
  }
  __syncthreads();
}

template <int BM, int BN, int WM, int WN, bool ATRANS, int BK>
__device__ __forceinline__ void gemm_main(const u16* A, int lda, const u16* Bt, int ldb, int K, int m0, int n0,
                                          u16* sA, u16* sB, f32x4 (&acc)[BM / WM / 16][BN / WN / 16]) {
  constexpr int MT = BM / WM / 16, NTL = BN / WN / 16;
  constexpr int CPR = BK / 8;
  constexpr int LDK = BK + 8;
  constexpr int ACH = BM * CPR / 256, BCH = BN * CPR / 256;
  const int tid = tidx(), lane = tid & 63, wave = __builtin_amdgcn_readfirstlane(tid >> 6);
  const int wm = wave / WN, wn = wave % WN;
  const int c = lane & 15, g = lane >> 4;
  U4 ra[ACH], rb[BCH];
  const int nk = K / BK;
  const int krot = (int)((unsigned)(blockIdx.x >> 3) % (unsigned)nk);
#pragma unroll
  for (int i = 0; i < ACH; ++i) {
    int ch = tid + i * 256;
    if (!ATRANS) { int row = ch / CPR, kc = ch % CPR; ra[i] = *(const U4*)(A + (size_t)(m0 + row) * lda + krot * BK + kc * 8); }
    else { int k = ch / (BM / 8), mc = ch % (BM / 8); ra[i] = *(const U4*)(A + (size_t)(krot * BK + k) * lda + m0 + mc * 8); }
  }
#pragma unroll
  for (int i = 0; i < BCH; ++i) {
    int ch = tid + i * 256; int row = ch / CPR, kc = ch % CPR;
    rb[i] = *(const U4*)(Bt + (size_t)(n0 + row) * ldb + krot * BK + kc * 8);
  }
  for (int kt = 0; kt < nk; ++kt) {
    __syncthreads();
#pragma unroll
    for (int i = 0; i < ACH; ++i) {
      int ch = tid + i * 256;
      if (!ATRANS) { int row = ch / CPR, kc = ch % CPR; *(U4*)(sA + row * LDK + kc * 8) = ra[i]; }
      else {
        int k = ch / (BM / 8), mc = ch % (BM / 8);
        u16* d = sA + (mc * 8) * LDK + k;
        d[0 * LDK] = (u16)(ra[i].x & 0xffff); d[1 * LDK] = (u16)(ra[i].x >> 16);
        d[2 * LDK] = (u16)(ra[i].y & 0xffff); d[3 * LDK] = (u16)(ra[i].y >> 16);
        d[4 * LDK] = (u16)(ra[i].z & 0xffff); d[5 * LDK] = (u16)(ra[i].z >> 16);
        d[6 * LDK] = (u16)(ra[i].w & 0xffff); d[7 * LDK] = (u16)(ra[i].w >> 16);
      }
    }
#pragma unroll
    for (int i = 0; i < BCH; ++i) {
      int ch = tid + i * 256; int row = ch / CPR, kc = ch % CPR;
      *(U4*)(sB + row * LDK + kc * 8) = rb[i];
    }
    __syncthreads();
    if (kt + 1 < nk) {
      int kn = kt + 1 + krot; if (kn >= nk) kn -= nk;
      const int k0 = kn * BK;
#pragma unroll
      for (int i = 0; i < ACH; ++i) {
        int ch = tid + i * 256;
        if (!ATRANS) { int row = ch / CPR, kc = ch % CPR; ra[i] = *(const U4*)(A + (size_t)(m0 + row) * lda + k0 + kc * 8); }
        else { int k = ch / (BM / 8), mc = ch % (BM / 8); ra[i] = *(const U4*)(A + (size_t)(k0 + k) * lda + m0 + mc * 8); }
      }
#pragma unroll
      for (int i = 0; i < BCH; ++i) {
        int ch = tid + i * 256; int row = ch / CPR, kc = ch % CPR;
        rb[i] = *(const U4*)(Bt + (size_t)(n0 + row) * ldb + k0 + kc * 8);
      }
    }
#pragma unroll
    for (int ks = 0; ks < BK / 32; ++ks) {
      bf16x8 af[MT], bfr[NTL];
#pragma unroll
      for (int mt = 0; mt < MT; ++mt) af[mt] = *(const bf16x8*)(sA + (wm * (BM / WM) + mt * 16 + c) * LDK + ks * 32 + g * 8);
#pragma unroll
      for (int nt = 0; nt < NTL; ++nt) bfr[nt] = *(const bf16x8*)(sB + (wn * (BN / WN) + nt * 16 + c) * LDK + ks * 32 + g * 8);
#pragma unroll
      for (int mt = 0; mt < MT; ++mt)
#pragma unroll
        for (int nt = 0; nt < NTL; ++nt)
          acc[mt][nt] = __builtin_amdgcn_mfma_f32_16x16x32_bf16(af[mt], bfr[nt], acc[mt][nt], 0, 0, 0);
    }
  }
}


template <int BM, int BN, int WM, int WN, bool SWAP = false>
__device__ __forceinline__ void gemm_glds(const u16* A, int lda, const u16* Bt, int ldb, int K, int m0, int n0,
                                          unsigned char* smem, f32x4 (&acc)[BM / WM / 16][BN / WN / 16]) {
  constexpr int MT = BM / WM / 16, NTL = BN / WN / 16;
  constexpr int TA = BM * 128, TB = BN * 128, STAGE = TA + TB;
  constexpr int GA = BM / 32, GB = BN / 32;
  const int tid = tidx(), lane = tid & 63, wave = __builtin_amdgcn_readfirstlane(tid >> 6);
  const int wm = wave / WN, wn = wave % WN;
  const int c = lane & 15, g = lane >> 4;
  const int rg = lane >> 3, kcs = ((lane & 7) ^ rg) * 8;
  const int nk = K / 64;
  const int krot = (int)((unsigned)(blockIdx.x >> 3) % (unsigned)nk);
  const u16* asrc = A + (size_t)(m0 + wave * 8 + rg) * lda + kcs;
  const u16* bsrc = Bt + (size_t)(n0 + wave * 8 + rg) * ldb + kcs;
#define GLDS_STAGE(buf, kt)                                                                                          \
  {                                                                                                                  \
    unsigned char* sa_ = smem + (buf) * STAGE + wave * 1024;                                                         \
    _Pragma("unroll") for (int i_ = 0; i_ < GA; ++i_)                                                                \
      __builtin_amdgcn_global_load_lds((const unsigned*)(asrc + (size_t)(i_ * 32) * lda + (kt) * 64),                \
                                       (unsigned*)(sa_ + i_ * 4096), 16, 0, 0);                                      \
    _Pragma("unroll") for (int i_ = 0; i_ < GB; ++i_)                                                                \
      __builtin_amdgcn_global_load_lds((const unsigned*)(bsrc + (size_t)(i_ * 32) * ldb + (kt) * 64),                \
                                       (unsigned*)(sa_ + TA + i_ * 4096), 16, 0, 0);                                 \
  }
  __syncthreads();
  GLDS_STAGE(0, krot)
  asm volatile("s_waitcnt vmcnt(0)" ::: "memory");
  __syncthreads();
#pragma unroll 4
  for (int kt = 0; kt < nk; ++kt) {
    const int cur = kt & 1;
    int kn = kt + 1 + krot; if (kn >= nk) kn -= nk;
    if (kt + 1 < nk) GLDS_STAGE(cur ^ 1, kn)
    const unsigned char* pa = smem + cur * STAGE;
    const unsigned char* pb = pa + TA;
#pragma unroll
    for (int ks = 0; ks < 2; ++ks) {
      bf16x8 af[MT], bfr[NTL];
      const int cho = (((ks * 4 + g) ^ (c & 7)) * 16);
#pragma unroll
      for (int mt = 0; mt < MT; ++mt) af[mt] = *(const bf16x8*)(pa + (wm * (BM / WM) + mt * 16 + c) * 128 + cho);
#pragma unroll
      for (int nt = 0; nt < NTL; ++nt) bfr[nt] = *(const bf16x8*)(pb + (wn * (BN / WN) + nt * 16 + c) * 128 + cho);
#pragma unroll
      for (int mt = 0; mt < MT; ++mt)
#pragma unroll
        for (int nt = 0; nt < NTL; ++nt)
          acc[mt][nt] = SWAP ? __builtin_amdgcn_mfma_f32_16x16x32_bf16(bfr[nt], af[mt], acc[mt][nt], 0, 0, 0)
                             : __builtin_amdgcn_mfma_f32_16x16x32_bf16(af[mt], bfr[nt], acc[mt][nt], 0, 0, 0);
    }
    asm volatile("s_waitcnt vmcnt(0)" ::: "memory");
    __syncthreads();
  }
#undef GLDS_STAGE
}

template <bool SWAP>
__device__ __forceinline__ void gemm_glds_at(const u16* At, int ldat, const u16* Bt, int ldb, int K, int m0, int n0,
                                             unsigned char* smem, f32x4 (&acc)[4][4]) {
  constexpr int IA = 1040, TA = 16 * IA, TB = 128 * 128, STAGE = TA + TB;
  const int tid = tidx(), lane = tid & 63, wave = __builtin_amdgcn_readfirstlane(tid >> 6);
  const int wm = wave >> 1, wn = wave & 1;
  const int c = lane & 15, g = lane >> 4;
  const int rg = lane >> 3, kcs = ((lane & 7) ^ rg) * 8;
  const int nk = K / 64;
  const int krot = (int)((unsigned)(blockIdx.x >> 3) % (unsigned)nk);
  const u16* asrc = At + (size_t)(wave * 4 + (lane >> 4)) * ldat + m0 + (lane & 15) * 8;
  const u16* bsrc = Bt + (size_t)(n0 + wave * 8 + rg) * ldb + kcs;
#define GLDS_STAGE_AT(buf, kt)                                                                                       \
  {                                                                                                                  \
    unsigned char* sa_ = smem + (buf) * STAGE;                                                                       \
    _Pragma("unroll") for (int i_ = 0; i_ < 4; ++i_)                                                                 \
      __builtin_amdgcn_global_load_lds((const unsigned*)(asrc + (size_t)((kt) * 64 + i_ * 16) * ldat),               \
                                       (unsigned*)(sa_ + (wave + i_ * 4) * IA), 16, 0, 0);                           \
    _Pragma("unroll") for (int i_ = 0; i_ < 4; ++i_)                                                                 \
      __builtin_amdgcn_global_load_lds((const unsigned*)(bsrc + (size_t)(i_ * 32) * ldb + (kt) * 64),                \
                                       (unsigned*)(sa_ + TA + wave * 1024 + i_ * 4096), 16, 0, 0);                   \
  }
  __syncthreads();
  GLDS_STAGE_AT(0, krot)
  asm volatile("s_waitcnt vmcnt(0)" ::: "memory");
  __syncthreads();
#pragma unroll 2
  for (int kt = 0; kt < nk; ++kt) {
    const int cur = kt & 1;
    int kn = kt + 1 + krot; if (kn >= nk) kn -= nk;
    if (kt + 1 < nk) GLDS_STAGE_AT(cur ^ 1, kn)
    const unsigned char* pa = smem + cur * STAGE;
    const unsigned char* pb = pa + TA;
#pragma unroll
    for (int ks = 0; ks < 2; ++ks) {
      bf16x8 af[4], bfr[4];
      const int cho = (((ks * 4 + g) ^ (c & 7)) * 16);
#pragma unroll
      for (int mt = 0; mt < 4; ++mt) {
        const unsigned char* q = pa + (ks * 8 + 2 * g) * IA + (wm * 64 + mt * 16 + c) * 2;
        const unsigned e0 = *(const u16*)(q), e1 = *(const u16*)(q + 256), e2 = *(const u16*)(q + 512), e3 = *(const u16*)(q + 768);
        const unsigned e4 = *(const u16*)(q + IA), e5 = *(const u16*)(q + IA + 256), e6 = *(const u16*)(q + IA + 512), e7 = *(const u16*)(q + IA + 768);
        U4 w = {e0 | (e1 << 16), e2 | (e3 << 16), e4 | (e5 << 16), e6 | (e7 << 16)};
        af[mt] = __builtin_bit_cast(bf16x8, w);
      }
#pragma unroll
      for (int nt = 0; nt < 4; ++nt) bfr[nt] = *(const bf16x8*)(pb + (wn * 64 + nt * 16 + c) * 128 + cho);
#pragma unroll
      for (int mt = 0; mt < 4; ++mt)
#pragma unroll
        for (int nt = 0; nt < 4; ++nt)
          acc[mt][nt] = SWAP ? __builtin_amdgcn_mfma_f32_16x16x32_bf16(bfr[nt], af[mt], acc[mt][nt], 0, 0, 0)
                             : __builtin_amdgcn_mfma_f32_16x16x32_bf16(af[mt], bfr[nt], acc[mt][nt], 0, 0, 0);
    }
    asm volatile("s_waitcnt vmcnt(0)" ::: "memory");
    __syncthreads();
  }
#undef GLDS_STAGE_AT
}

__device__ __forceinline__ void ph_x_prep(const Params& p, int bid, int nb) {
  const int lane = tidx() & 63, wave = __builtin_amdgcn_readfirstlane(tidx() >> 6);
  for (int r = (bid * 4 + wave) * 2; r < T_TOK; r += nb * 8) {
    const F4* xr = (const F4*)(p.x + (size_t)r * 1024);
    F4 v[8]; float ss0 = 0.f, ss1 = 0.f;
#pragma unroll
    for (int i = 0; i < 8; ++i) v[i] = xr[lane + 64 * i];
#pragma unroll
    for (int i = 0; i < 4; ++i) {
      ss0 += v[i].x * v[i].x + v[i].y * v[i].y + v[i].z * v[i].z + v[i].w * v[i].w;
      ss1 += v[4 + i].x * v[4 + i].x + v[4 + i].y * v[4 + i].y + v[4 + i].z * v[4 + i].z + v[4 + i].w * v[4 + i].w;
    }
    ss0 = wave_sum(ss0); ss1 = wave_sum(ss1);
    if (lane == 0) { p.rstd1[r] = rsqrtf(ss0 * (1.f / 1024.f) + EPS); p.rstd1[r + 1] = rsqrtf(ss1 * (1.f / 1024.f) + EPS); }
#pragma unroll
    for (int i = 0; i < 8; ++i) {
      const F4 g4 = ((const F4*)p.attn_norm)[lane + 64 * (i & 3)];
      U2 o; o.x = pack2(v[i].x * g4.x, v[i].y * g4.y); o.y = pack2(v[i].z * g4.z, v[i].w * g4.w);
      ((U2*)(p.xb + (size_t)r * 1024))[lane + 64 * i] = o;
    }
  }
}

__device__ __forceinline__ void ph_transpose(const float* W, int K, int N, int Npad, u16* Wt, const float* ks, float* tile, int bid, int nb) {
  const int ntk = K / 64, ntn = Npad / 64;
  for (int it = bid; it < ntk * ntn; it += nb) {
    const int kt = it % ntk, nt = it / ntk; const int k0 = kt * 64, n0 = nt * 64;
    __syncthreads();
    for (int e = tidx(); e < 4096; e += 256) {
      int i = e >> 6, j = e & 63; int n = n0 + j;
      float v = (n < N) ? W[(size_t)(k0 + i) * N + n] : 0.f;
      if (ks) v *= ks[k0 + i];
      tile[i * 65 + j] = v;
    }
    __syncthreads();
    for (int e = tidx(); e < 4096; e += 256) {
      int j = e >> 6, i = e & 63;
      Wt[(size_t)(n0 + j) * K + k0 + i] = f2bf(tile[i * 65 + j]);
    }
  }
}

__device__ __forceinline__ void ph_convert(const float* src, u16* dst, size_t n4, int bid, int nb) {
  for (size_t i = (size_t)bid * 256 + tidx(); i < n4; i += (size_t)nb * 256) {
    F4 v = ((const F4*)src)[i];
    U2 o; o.x = pack2(v.x, v.y); o.y = pack2(v.z, v.w);
    ((U2*)dst)[i] = o;
  }
}

__device__ __forceinline__ void ph_filter_trunk(const Params& p, float* sm, int bid, int nb) {
  const int sub = __builtin_amdgcn_readfirstlane(tidx() >> 6), o = tidx() & 63;
  float* bufA = sm + sub * 128; float* bufB = bufA + 64;
  const float fr = p.ffreq[o];
  for (int it = bid; it < 512; it += nb) {
    const int t = it * 4 + sub;
    __syncthreads();
    if (o < 33) {
      float zv;
      if (o == 0) zv = (float)t / 2047.f;
      else {
        int i = (o - 1) & 15;
        float f = 1e-4f + (float)i * ((15.f - 1e-4f) / 15.f);
        float w = 6.283185307179586f * (float)t / 2048.f;
        float a = f * w;
        zv = (o <= 16) ? cosf(a) : -sinf(a);
      }
      bufA[o] = zv;
    }
    __syncthreads();
    float s = p.fb1[o];
#pragma unroll 11
    for (int k = 0; k < 33; ++k) s += bufA[k] * p.fw1[k * 64 + o];
    bufB[o] = sinf(fr * s);
    __syncthreads();
    s = p.fb2[o];
#pragma unroll 16
    for (int k = 0; k < 64; ++k) s += bufB[k] * p.fw2[k * 64 + o];
    bufA[o] = sinf(fr * s);
    __syncthreads();
    s = p.fb3[o];
#pragma unroll 16
    for (int k = 0; k < 64; ++k) s += bufA[k] * p.fw3[k * 64 + o];
    p.h3[t * 64 + o] = sinf(fr * s);
  }
}

__device__ __forceinline__ void phase0(const Params& p, unsigned char* smem, int bid, int nb) {
  float* tile = (float*)smem;
  ph_x_prep(p, bid, nb);
  ph_transpose(p.w_in, 1024, 4000, 4096, p.w_inT, nullptr, tile, bid, nb);
  ph_transpose(p.w_uq, 256, 768, 768, p.w_uqT, p.q_a_norm, tile, (bid + 64) % nb, nb);
  ph_transpose(p.w_ukv, 128, 1024, 1024, p.w_ukvT, p.kv_a_norm, tile, (bid + 128) % nb, nb);
  ph_transpose(p.w_o_attn, 512, 1024, 1024, p.w_oaT, nullptr, tile, (bid + 160) % nb, nb);
  ph_transpose(p.w_o_hyena, 512, 1024, 1024, p.w_ohT, nullptr, tile, (bid + 32) % nb, nb);
  ph_transpose(p.w_out, 1024, 1024, 1024, p.w_outT, nullptr, tile, (bid + 96) % nb, nb);
  ph_convert(p.peer_wq, p.wqb, (size_t)1024 * 2048 / 4, bid, nb);
  ph_convert(p.keys1, p.keysb, (size_t)8 * 128 * 128 / 4, bid, nb);
  ph_convert(p.keys2, p.keysb + 8 * 128 * 128, (size_t)8 * 128 * 128 / 4, bid, nb);
  __syncthreads();
  ph_filter_trunk(p, tile, nb - 1 - bid, nb);
}

__device__ __forceinline__ void filter_item(const Params& p, unsigned char* smem, int j) {
  const int tid = tidx();
  const int cp = (j & 3) * 256 + tid, t0 = (j >> 2) * 8;
  const int c = cp & 511;
  float* hl = (float*)smem;
  __syncthreads();
  {
    const float2 v = *(const float2*)(p.h3 + (size_t)t0 * 64 + tid * 2);
    hl[tid * 2] = v.x; hl[tid * 2 + 1] = v.y;
  }
  float w[64];
#pragma unroll
  for (int k = 0; k < 64; ++k) w[k] = p.fw4[k * 1024 + cp];
  const float dmin = -3.0701134573253943f, dmax = -15.350567286626972f;
  const float delta = fabsf(dmin + (float)c * ((dmax - dmin) / 511.f));
  const float b4 = p.fb4[cp];
  __syncthreads();
  float o[8];
#pragma unroll
  for (int i = 0; i < 8; ++i) {
    const int t = t0 + i;
    float sacc = 0.f;
#pragma unroll
    for (int k4 = 0; k4 < 16; ++k4) { const F4 hv = *(const F4*)(hl + i * 64 + k4 * 4); sacc += hv.x * w[k4 * 4] + hv.y * w[k4 * 4 + 1] + hv.z * w[k4 * 4 + 2] + hv.w * w[k4 * 4 + 3]; }
    float v = (sacc + b4) * expf(-((float)t / 2047.f) * delta);
    if (t == 0 && cp < 512) v += p.hbias[c];
    o[i] = v;
  }
  U4 ov; ov.x = pack2(o[0], o[1]); ov.y = pack2(o[2], o[3]); ov.z = pack2(o[4], o[5]); ov.w = pack2(o[6], o[7]);
  *(U4*)(p.filt + (size_t)cp * 2048 + t0) = ov;
}

__device__ __forceinline__ void qkv_items(const Params& p, unsigned char* smem, int bid, int nb);
template <int MODE>
__device__ __forceinline__ void phase1(const Params& p, unsigned char* smem, int bid, int nb) {
  const int lane = tidx() & 63, wave = __builtin_amdgcn_readfirstlane(tidx() >> 6);
  const int wm = wave >> 1, wn = wave & 1, c = lane & 15, g = lane >> 4;
  const int NTILES = (MODE == 0) ? 512 : 3584;
  const int NITEMS = (MODE == 0) ? NTILES : NTILES + 128 + 1024;
  if (MODE == 1 && bid >= (nb >> 1)) qkv_items(p, smem, bid, nb);
  for (int it = bid; it < NITEMS; it += nb) {
    if (it >= NTILES + 128) { filter_item(p, smem, it - NTILES - 128); continue; }
    f32x4 acc[4][4];
#pragma unroll
    for (int i = 0; i < 4; ++i)
#pragma unroll
      for (int j = 0; j < 4; ++j) acc[i][j] = f32x4{0.f, 0.f, 0.f, 0.f};
    if (it < NTILES) {
      const int rr_ = it >> 9, xx_ = it & 7, li_ = (it & 511) >> 3;
      const int ntile = ((MODE == 0) ? 0 : 4 + 4 * rr_) + (li_ >> 4);
      const int m0 = (16 * xx_ + (li_ & 15)) * 128, n0 = ntile * 128;
      if (ntile < 3 || ntile >= 16) {
        gemm_glds<128, 128, 2, 2, true>(p.xb, 1024, p.w_inT, 1024, 1024, m0, n0, smem, acc);
#pragma unroll
        for (int mt = 0; mt < 4; ++mt) {
          const int t = m0 + wm * 64 + mt * 16 + c;
          const float rs = p.rstd1[t];
#pragma unroll
          for (int nt = 0; nt < 4; ++nt) {
            const int n = n0 + wn * 64 + nt * 16 + g * 4;
            float v[4];
#pragma unroll
            for (int r = 0; r < 4; ++r) v[r] = acc[mt][nt][r] * rs;
            if (ntile < 2) {
              U2 o; o.x = pack2(v[0], v[1]); o.y = pack2(v[2], v[3]);
              *(U2*)(p.cq + (size_t)t * 256 + n) = o;
            } else if (ntile == 2) {
              U2 o; o.x = pack2(v[0], v[1]); o.y = pack2(v[2], v[3]);
              *(U2*)(p.ckv + (size_t)t * 160 + (n - 256)) = o;
            } else if (n < 4000) {
              const F4 bg = *(const F4*)(p.b_gate + (n - 1952));
              const float s0 = 1.f / (1.f + __expf(-(v[0] + bg.x))), s1 = 1.f / (1.f + __expf(-(v[1] + bg.y)));
              const float s2 = 1.f / (1.f + __expf(-(v[2] + bg.z))), s3 = 1.f / (1.f + __expf(-(v[3] + bg.w)));
              U2 o; o.x = pack2(s0, s1); o.y = pack2(s2, s3);
              *(U2*)(p.gates + (size_t)t * 2048 + (n - 1952)) = o;
            }
          }
        }
        continue;
      }
      gemm_glds<128, 128, 2, 2>(p.xb, 1024, p.w_inT, 1024, 1024, m0, n0, smem, acc);
#pragma unroll
      for (int mt = 0; mt < 4; ++mt) {
        const int t0 = m0 + wm * 64 + mt * 16 + g * 4;
        float rs[4];
#pragma unroll
        for (int r = 0; r < 4; ++r) rs[r] = p.rstd1[t0 + r];
#pragma unroll
        for (int nt = 0; nt < 4; ++nt) {
          const int nb0 = n0 + wn * 64 + nt * 16;
          const int n = nb0 + c;
          float v[4];
#pragma unroll
          for (int r = 0; r < 4; ++r) v[r] = acc[mt][nt][r] * rs[r];
          if (nb0 < 256) {
#pragma unroll
            for (int r = 0; r < 4; ++r) p.cq[(size_t)(t0 + r) * 256 + n] = f2bf(v[r]);
          } else if (nb0 < 416) {
#pragma unroll
            for (int r = 0; r < 4; ++r) p.ckv[(size_t)(t0 + r) * 160 + (n - 256)] = f2bf(v[r]);
          } else if (nb0 < 1952) {
            U2 o; o.x = pack2(v[0], v[1]); o.y = pack2(v[2], v[3]);
            *(U2*)(p.uT + (size_t)(n - 416) * T_TOK + t0) = o;
          } else if (nb0 < 4000) {
            const float bg = p.b_gate[n - 1952];
#pragma unroll
            for (int r = 0; r < 4; ++r) {
              float s = 1.f / (1.f + __expf(-(v[r] + bg)));
              p.gates[(size_t)(t0 + r) * 2048 + (n - 1952)] = f2bf(s);
            }
          }
        }
      }
    } else {
      const int j = it - NTILES; const int hs = j >> 3, kt = j & 7; const int h = hs >> 1, side = hs & 1;
      const u16* A = p.keysb + (size_t)((side * 8 + h) * 128) * 128;
      const u16* Bt = p.wqb + h * 256 + side * 128;
      gemm_glds<128, 128, 2, 2>(A, 128, Bt, 2048, 128, 0, kt * 128, smem, acc);
#pragma unroll
      for (int mt = 0; mt < 4; ++mt)
#pragma unroll
        for (int nt = 0; nt < 4; ++nt)
#pragma unroll
          for (int r = 0; r < 4; ++r) {
            int key = wm * 64 + mt * 16 + g * 4 + r; int k = kt * 128 + wn * 64 + nt * 16 + c;
            p.wcT[(size_t)(h * 256 + side * 128 + key) * 1024 + k] = f2bf(acc[mt][nt][r]);
          }
    }
  }
  if (MODE == 1 && bid < (nb >> 1)) qkv_items(p, smem, bid, nb);
}

__device__ __forceinline__ void hyena_channel(const Params& p, unsigned char* smem, int c) {
  u16* Zl = (u16*)smem;
  u16* R0 = (u16*)(smem + 36864);
  u16* R1 = (u16*)(smem + 36864 + 8192);
  const int tid = tidx(), lane = tid & 63, wave = __builtin_amdgcn_readfirstlane(tid >> 6);
  __syncthreads();
  if (tid == 0) { R0[0] = 0; R1[4095] = 0; }
  {
    const float w1a = p.conv_w[512 + c], w1b = p.conv_w[1536 + 512 + c], w1c = p.conv_w[3072 + 512 + c], b1 = p.conv_b[512 + c];
    const float wva = p.conv_w[1024 + c], wvb = p.conv_w[1536 + 1024 + c], wvc = p.conv_w[3072 + 1024 + c], bv = p.conv_b[1024 + c];
    const int s0 = tid * 8;
#pragma unroll 4
    for (int b = 0; b < 8; ++b) {
      const u16* u1 = p.uT + (size_t)(512 + c) * T_TOK + b * SEQ;
      const u16* uv = p.uT + (size_t)(1024 + c) * T_TOK + b * SEQ;
      U4 a = *(const U4*)(u1 + s0), d = *(const U4*)(uv + s0);
      float x[10], y[10];
      x[0] = (s0 > 0) ? bf2f(u1[s0 - 1]) : 0.f; y[0] = (s0 > 0) ? bf2f(uv[s0 - 1]) : 0.f;
      x[9] = (s0 + 8 < SEQ) ? bf2f(u1[s0 + 8]) : 0.f; y[9] = (s0 + 8 < SEQ) ? bf2f(uv[s0 + 8]) : 0.f;
      x[1] = bflo(a.x); x[2] = bfhi(a.x); x[3] = bflo(a.y); x[4] = bfhi(a.y); x[5] = bflo(a.z); x[6] = bfhi(a.z); x[7] = bflo(a.w); x[8] = bfhi(a.w);
      y[1] = bflo(d.x); y[2] = bfhi(d.x); y[3] = bflo(d.y); y[4] = bfhi(d.y); y[5] = bflo(d.z); y[6] = bfhi(d.z); y[7] = bflo(d.w); y[8] = bfhi(d.w);
      float z[8];
#pragma unroll
      for (int i = 0; i < 8; ++i) {
        float x1 = w1a * x[i] + w1b * x[i + 1] + w1c * x[i + 2] + b1;
        float vv = wva * y[i] + wvb * y[i + 1] + wvc * y[i + 2] + bv;
        z[i] = x1 * vv;
      }
      U4 o; o.x = pack2(z[0], z[1]); o.y = pack2(z[2], z[3]); o.z = pack2(z[4], z[5]); o.w = pack2(z[6], z[7]);
      *(U4*)(Zl + b * ZS + 96 + s0) = o;
      if (tid < 200) { int idx = (tid < 96) ? tid : (SEQ + tid); Zl[b * ZS + idx] = 0; }
    }
  }
  __syncthreads();
  {
    const int t0 = tid * 8;
    const U4 ff = *(const U4*)(p.filt + (size_t)c * 2048 + t0);
    const U4 fb = *(const U4*)(p.filt + (size_t)(512 + c) * 2048 + t0);
    u16 f[8], bw[8];
    f[0] = (u16)(ff.x & 0xffff); f[1] = (u16)(ff.x >> 16); f[2] = (u16)(ff.y & 0xffff); f[3] = (u16)(ff.y >> 16);
    f[4] = (u16)(ff.z & 0xffff); f[5] = (u16)(ff.z >> 16); f[6] = (u16)(ff.w & 0xffff); f[7] = (u16)(ff.w >> 16);
    bw[0] = (u16)(fb.x & 0xffff); bw[1] = (u16)(fb.x >> 16); bw[2] = (u16)(fb.y & 0xffff); bw[3] = (u16)(fb.y >> 16);
    bw[4] = (u16)(fb.z & 0xffff); bw[5] = (u16)(fb.z >> 16); bw[6] = (u16)(fb.w & 0xffff); bw[7] = (u16)(fb.w >> 16);
#pragma unroll
    for (int i = 0; i < 8; ++i) {
      const int t = t0 + i;
      R0[2048 - t] = f[i]; R1[2047 - t] = f[i];
      if (t >= 1) { R0[2048 + t] = bw[i]; R1[2047 + t] = bw[i]; }
    }
  }
  __syncthreads();
  f32x16 acc[4];
#pragma unroll
  for (int i = 0; i < 4; ++i)
#pragma unroll
    for (int j = 0; j < 16; ++j) acc[i][j] = 0.f;
  const int r = lane & 31, hh = lane >> 5;
  const int bb = r >> 2, ii = r & 3;
  {
    const unsigned* Rw = (const unsigned*)((r & 1) ? R1 : R0);
    const int abase = (2048 - r + 8 * hh - (r & 1)) >> 1;
    const u16* zb = Zl + bb * ZS + 96 + 32 * ii + 8 * hh;
    const int dlo = 16 * wave - 63, dhi = 16 * wave + 15;
#pragma unroll 1
    for (int d = dlo; d <= dhi; ++d) {
      bf16x8 a0, a1;
      {
        const unsigned* q = Rw + abase - 16 * d;
        unsigned w0 = q[0], w1 = q[1], w2 = q[2], w3 = q[3], w4 = q[8], w5 = q[9], w6 = q[10], w7 = q[11];
        typedef __attribute__((ext_vector_type(4))) unsigned u32x4;
        u32x4 t0 = {w0, w1, w2, w3}, t1 = {w4, w5, w6, w7};
        a0 = __builtin_bit_cast(bf16x8, t0); a1 = __builtin_bit_cast(bf16x8, t1);
      }
#pragma unroll
      for (int nt = 0; nt < 4; ++nt) {
        const int i0 = 16 * wave + 4 * nt;
        if (d >= i0 - 63 && d <= i0 + 3) {
          const u16* zp = zb + 32 * (i0 - d);
          bf16x8 b0 = *(const bf16x8*)(zp);
          bf16x8 b1 = *(const bf16x8*)(zp + 16);
          acc[nt] = __builtin_amdgcn_mfma_f32_32x32x16_bf16(a0, b0, acc[nt], 0, 0, 0);
          acc[nt] = __builtin_amdgcn_mfma_f32_32x32x16_bf16(a1, b1, acc[nt], 0, 0, 0);
        }
      }
    }
  }
  __syncthreads();
  {
    const float w0a = p.conv_w[c], w0b = p.conv_w[1536 + c], w0c = p.conv_w[3072 + c], b0 = p.conv_b[c];
    const int s0 = tid * 8;
#pragma unroll 8
    for (int b = 0; b < 8; ++b) {
      const u16* u0 = p.uT + (size_t)c * T_TOK + b * SEQ;
      U4 a = *(const U4*)(u0 + s0);
      float x[10];
      x[0] = (s0 > 0) ? bf2f(u0[s0 - 1]) : 0.f;
      x[9] = (s0 + 8 < SEQ) ? bf2f(u0[s0 + 8]) : 0.f;
      x[1] = bflo(a.x); x[2] = bfhi(a.x); x[3] = bflo(a.y); x[4] = bfhi(a.y); x[5] = bflo(a.z); x[6] = bfhi(a.z); x[7] = bflo(a.w); x[8] = bfhi(a.w);
      float z[8];
#pragma unroll
      for (int i = 0; i < 8; ++i) z[i] = w0a * x[i] + w0b * x[i + 1] + w0c * x[i + 2] + b0;
      U4 o; o.x = pack2(z[0], z[1]); o.y = pack2(z[2], z[3]); o.z = pack2(z[4], z[5]); o.w = pack2(z[6], z[7]);
      *(U4*)(Zl + b * ZS + 96 + s0) = o;
    }
  }
  __syncthreads();
#pragma unroll
  for (int nt = 0; nt < 4; ++nt) {
    const int i0 = 16 * wave + 4 * nt;
#pragma unroll
    for (int rg = 0; rg < 4; ++rg) {
      const int ts = 32 * (i0 + ii) + 8 * rg + 4 * hh;
      U2 xv = *(const U2*)(Zl + bb * ZS + 96 + ts);
      U2 o;
      o.x = pack2(acc[nt][rg * 4 + 0] * bflo(xv.x), acc[nt][rg * 4 + 1] * bfhi(xv.x));
      o.y = pack2(acc[nt][rg * 4 + 2] * bflo(xv.y), acc[nt][rg * 4 + 3] * bfhi(xv.y));
      *(U2*)(p.yhT + (size_t)c * T_TOK + bb * SEQ + ts) = o;
    }
  }
}

__device__ __forceinline__ void q_tile(const Params& p, unsigned char* smem, int mtile, int h) {
  u16* sA = (u16*)smem; u16* sB = (u16*)(smem + OFF_SB); float* rsq = (float*)(smem + OFF_RS);
  const int tid = tidx(), lane = tid & 63, wave = __builtin_amdgcn_readfirstlane(tid >> 6), c = lane & 15, g = lane >> 4;
  const int m0 = mtile * 128;
  __syncthreads();
  {
    const int row = tid >> 1, half = tid & 1;
    const U4* src = (const U4*)(p.cq + (size_t)(m0 + row) * 256 + half * 128);
    float ss = 0.f;
#pragma unroll
    for (int i = 0; i < 16; ++i) {
      U4 v = src[i];
      float a;
      a = bflo(v.x); ss += a * a; a = bfhi(v.x); ss += a * a; a = bflo(v.y); ss += a * a; a = bfhi(v.y); ss += a * a;
      a = bflo(v.z); ss += a * a; a = bfhi(v.z); ss += a * a; a = bflo(v.w); ss += a * a; a = bfhi(v.w); ss += a * a;
    }
    ss += __shfl_xor(ss, 1);
    if (half == 0) rsq[row] = rsqrtf(ss * (1.f / 256.f) + EPS);
  }
  f32x4 acc[2][6];
#pragma unroll
  for (int i = 0; i < 2; ++i)
#pragma unroll
    for (int j = 0; j < 6; ++j) acc[i][j] = f32x4{0.f, 0.f, 0.f, 0.f};
  gemm_main<128, 96, 4, 1, false, 128>(p.cq, 256, p.w_uqT, 256, 256, m0, h * 96, sA, sB, acc);
  const float QSCALE = 0.10206207261596575f * 1.4426950408889634f;
  const float invf = powf(10000.f, -(float)c / 16.f);
  float gn[6];
#pragma unroll
  for (int nt = 0; nt < 6; ++nt) gn[nt] = p.q_norm[nt * 16 + c];
#pragma unroll
  for (int mt = 0; mt < 2; ++mt)
#pragma unroll
    for (int r = 0; r < 4; ++r) {
      const int rl = wave * 32 + mt * 16 + g * 4 + r;
      const int t = m0 + rl; const int b = t >> 11, s = t & 2047;
      const float rs = rsq[rl];
      float q[6]; float ss = 0.f;
#pragma unroll
      for (int nt = 0; nt < 6; ++nt) { q[nt] = acc[mt][nt][r] * rs; ss += q[nt] * q[nt]; }
      ss = sum16(ss);
      const float rn = rsqrtf(ss * (1.f / 96.f) + EPS);
      u16* dst = p.Q + ((size_t)(b * 8 + h) * SEQ + s) * 96;
#pragma unroll
      for (int nt = 0; nt < 4; ++nt) dst[nt * 16 + c] = f2bf(q[nt] * rn * gn[nt] * QSCALE);
      const float x1 = q[4] * rn * gn[4], x2 = q[5] * rn * gn[5];
      float sn, cs; sincosf((float)s * invf, &sn, &cs);
      dst[64 + c] = f2bf((x1 * cs - x2 * sn) * QSCALE);
      dst[80 + c] = f2bf((x2 * cs + x1 * sn) * QSCALE);
    }
}

__device__ __forceinline__ void kv_tile(const Params& p, unsigned char* smem, int mtile, int h) {
  u16* sA = (u16*)smem; u16* sB = (u16*)(smem + OFF_SB); float* rsq = (float*)(smem + OFF_RS);
  const int tid = tidx(), lane = tid & 63, wave = __builtin_amdgcn_readfirstlane(tid >> 6), c = lane & 15, g = lane >> 4;
  const int wm = wave >> 1, wn = wave & 1;
  const int m0 = mtile * 128;
  __syncthreads();
  {
    const int row = tid >> 1, half = tid & 1;
    const U4* src = (const U4*)(p.ckv + (size_t)(m0 + row) * 160 + half * 64);
    float ss = 0.f;
#pragma unroll
    for (int i = 0; i < 8; ++i) {
      U4 v = src[i];
      float a;
      a = bflo(v.x); ss += a * a; a = bfhi(v.x); ss += a * a; a = bflo(v.y); ss += a * a; a = bfhi(v.y); ss += a * a;
      a = bflo(v.z); ss += a * a; a = bfhi(v.z); ss += a * a; a = bflo(v.w); ss += a * a; a = bfhi(v.w); ss += a * a;
    }
    ss += __shfl_xor(ss, 1);
    if (half == 0) rsq[row] = rsqrtf(ss * (1.f / 128.f) + EPS);
  }
  f32x4 acc[4][4];
#pragma unroll
  for (int i = 0; i < 4; ++i)
#pragma unroll
    for (int j = 0; j < 4; ++j) acc[i][j] = f32x4{0.f, 0.f, 0.f, 0.f};
  gemm_main<128, 128, 2, 2, false, 128>(p.ckv, 160, p.w_ukvT, 128, 128, m0, h * 128, sA, sB, acc);
  if (wn == 0) {
    const float invf = powf(10000.f, -(float)c / 16.f);
    float gn[6];
#pragma unroll
    for (int nt = 0; nt < 6; ++nt) gn[nt] = p.k_norm[nt * 16 + c];
#pragma unroll
    for (int mt = 0; mt < 4; ++mt)
#pragma unroll
      for (int r = 0; r < 4; ++r) {
        const int rl = wm * 64 + mt * 16 + g * 4 + r;
        const int t = m0 + rl; const int b = t >> 11, s = t & 2047;
        const float rs = rsq[rl];
        float kn[4]; float ss = 0.f;
#pragma unroll
        for (int nt = 0; nt < 4; ++nt) { kn[nt] = acc[mt][nt][r] * rs; ss += kn[nt] * kn[nt]; }
        const float pe1 = bf2f(p.ckv[(size_t)t * 160 + 128 + c]), pe2 = bf2f(p.ckv[(size_t)t * 160 + 144 + c]);
        ss += pe1 * pe1 + pe2 * pe2;
        ss = sum16(ss);
        const float rn = rsqrtf(ss * (1.f / 96.f) + EPS);
        u16* dst = p.K + ((size_t)(b * 8 + h) * SEQ + s) * 96;
#pragma unroll
        for (int nt = 0; nt < 4; ++nt) dst[nt * 16 + c] = f2bf(kn[nt] * rn * gn[nt]);
        const float x1 = pe1 * rn * gn[4], x2 = pe2 * rn * gn[5];
        float sn, cs; sincosf((float)s * invf, &sn, &cs);
        dst[64 + c] = f2bf(x1 * cs - x2 * sn);
        dst[80 + c] = f2bf(x2 * cs + x1 * sn);
      }
  } else {
#pragma unroll
    for (int mt = 0; mt < 4; ++mt) {
      const int rl = wm * 64 + mt * 16 + g * 4;
      const int t = m0 + rl; const int b = t >> 11, s = t & 2047;
      float rs[4];
#pragma unroll
      for (int r = 0; r < 4; ++r) rs[r] = rsq[rl + r];
#pragma unroll
      for (int nt = 0; nt < 4; ++nt) {
        const int dcol = nt * 16 + c;
        U2 o; o.x = pack2(acc[mt][nt][0] * rs[0], acc[mt][nt][1] * rs[1]); o.y = pack2(acc[mt][nt][2] * rs[2], acc[mt][nt][3] * rs[3]);
        *(U2*)(p.Vt + ((size_t)(b * 8 + h) * 64 + dcol) * SEQ + s) = o;
      }
    }
  }
}

__device__ __forceinline__ void qkv_items(const Params& p, unsigned char* smem, int bid, int nb) {
  for (int it = bid; it < 1024 + 1024; it += nb) {
    if (it < 1024) { q_tile(p, smem, it >> 3, it & 7); }
    else { int j = it - 1024; kv_tile(p, smem, j >> 3, j & 7); }
  }
}

typedef float f32x2 __attribute__((ext_vector_type(2)));
__device__ __forceinline__ void ph_expert_fp8(const float* src, unsigned char* dst, float* inv_scale, int bid, int nb) {
  const int tid = tidx(), lane = tid & 63, wave = __builtin_amdgcn_readfirstlane(tid >> 6);
  for (int r = bid * 4 + wave; r < 16384; r += nb * 4) {
    const F4* sr = (const F4*)(src + (size_t)r * 1024 + lane * 16);
    F4 v[4]; float mx = 0.f;
#pragma unroll
    for (int i = 0; i < 4; ++i) { v[i] = sr[i]; mx = fmaxf(mx, fmaxf(fmaxf(fabsf(v[i].x), fabsf(v[i].y)), fmaxf(fabsf(v[i].z), fabsf(v[i].w)))); }
#pragma unroll
    for (int o = 32; o > 0; o >>= 1) mx = fmaxf(mx, __shfl_xor(mx, o));
    const float sc = (mx > 0.f) ? 224.f / mx : 1.f;
    if (lane == 0) inv_scale[r] = (mx > 0.f) ? mx * (1.f / 224.f) : 1.f;
    U4 o;
#pragma unroll
    for (int i = 0; i < 4; ++i) {
      int w = __builtin_amdgcn_cvt_pk_fp8_f32(v[i].x * sc, v[i].y * sc, 0, false);
      w = __builtin_amdgcn_cvt_pk_fp8_f32(v[i].z * sc, v[i].w * sc, w, true);
      o[i] = (unsigned)w;
    }
    *(U4*)(dst + (size_t)r * 1024 + lane * 16) = o;
  }
}

__device__ __forceinline__ void phase3(const Params& p, unsigned char* smem, int bid, int nb) {
  constexpr int KS = 104, VS = 72;
  u16* sK = (u16*)smem;
  u16* sV = (u16*)(smem + 13312);
  const int tid = tidx(), lane = tid & 63, wave = __builtin_amdgcn_readfirstlane(tid >> 6), c = lane & 15, g = lane >> 4;
  if (bid >= (nb >> 1)) { for (int ch = bid; ch < 512; ch += nb) hyena_channel(p, smem, ch); }
  for (int it = bid; it < 1024; it += nb) {
    const int qb = it & 15, bh = it >> 4;
    const u16* Qp = p.Q + ((size_t)bh * SEQ + qb * 128 + wave * 32) * 96;
    const u16* Kp = p.K + (size_t)bh * SEQ * 96;
    const u16* Vp = p.Vt + (size_t)bh * 64 * SEQ;
    bf16x8 qf[2][3];
#pragma unroll
    for (int qt = 0; qt < 2; ++qt)
#pragma unroll
      for (int ks = 0; ks < 3; ++ks) qf[qt][ks] = *(const bf16x8*)(Qp + (size_t)(qt * 16 + c) * 96 + ks * 32 + g * 8);
    f32x4 O[4][2];
#pragma unroll
    for (int i = 0; i < 4; ++i)
#pragma unroll
      for (int j = 0; j < 2; ++j) O[i][j] = f32x4{0.f, 0.f, 0.f, 0.f};
    float mrun[2] = {-1e30f, -1e30f}, lrun[2] = {0.f, 0.f};
    U4 rk[3], rv[2];
    const int krot = (blockIdx.x >> 3) & 31;
#pragma unroll
    for (int i = 0; i < 3; ++i) { int ch = tid + i * 256; int row = ch / 12, kc = ch % 12; rk[i] = *(const U4*)(Kp + (size_t)(krot * 64 + row) * 96 + kc * 8); }
#pragma unroll
    for (int i = 0; i < 2; ++i) { int ch = tid + i * 256; int row = ch >> 3, kc = ch & 7; rv[i] = *(const U4*)(Vp + (size_t)row * SEQ + krot * 64 + kc * 8); }
    for (int kt = 0; kt < 32; ++kt) {
      __syncthreads();
#pragma unroll
      for (int i = 0; i < 3; ++i) { int ch = tid + i * 256; int row = ch / 12, kc = ch % 12; *(U4*)(sK + row * KS + kc * 8) = rk[i]; }
#pragma unroll
      for (int i = 0; i < 2; ++i) { int ch = tid + i * 256; int row = ch >> 3, kc = ch & 7; *(U4*)(sV + row * VS + kc * 8) = rv[i]; }
      __syncthreads();
      if (kt + 1 < 32) {
        const int k0 = ((kt + 1 + krot) & 31) * 64;
#pragma unroll
        for (int i = 0; i < 3; ++i) { int ch = tid + i * 256; int row = ch / 12, kc = ch % 12; rk[i] = *(const U4*)(Kp + (size_t)(k0 + row) * 96 + kc * 8); }
#pragma unroll
        for (int i = 0; i < 2; ++i) { int ch = tid + i * 256; int row = ch >> 3, kc = ch & 7; rv[i] = *(const U4*)(Vp + (size_t)row * SEQ + k0 + kc * 8); }
      }
      f32x4 S[4][2];
#pragma unroll
      for (int i = 0; i < 4; ++i)
#pragma unroll
        for (int j = 0; j < 2; ++j) S[i][j] = f32x4{0.f, 0.f, 0.f, 0.f};
#pragma unroll
      for (int ks = 0; ks < 3; ++ks)
#pragma unroll
        for (int k4 = 0; k4 < 4; ++k4) {
          bf16x8 kf = *(const bf16x8*)(sK + (k4 * 16 + c) * KS + ks * 32 + g * 8);
          S[k4][0] = __builtin_amdgcn_mfma_f32_16x16x32_bf16(kf, qf[0][ks], S[k4][0], 0, 0, 0);
          S[k4][1] = __builtin_amdgcn_mfma_f32_16x16x32_bf16(kf, qf[1][ks], S[k4][1], 0, 0, 0);
        }
      bf16x8 pf[2][2];
#pragma unroll
      for (int qt = 0; qt < 2; ++qt) {
        float mx = S[0][qt][0];
#pragma unroll
        for (int k4 = 0; k4 < 4; ++k4)
#pragma unroll
          for (int r = 0; r < 4; ++r) mx = fmaxf(mx, S[k4][qt][r]);
        {
          const auto r16_ = __builtin_amdgcn_permlane16_swap(__float_as_uint(mx), __float_as_uint(mx), false, false);
          mx = fmaxf(__uint_as_float(r16_[0]), __uint_as_float(r16_[1]));
          const auto r32_ = __builtin_amdgcn_permlane32_swap(__float_as_uint(mx), __float_as_uint(mx), false, false);
          mx = fmaxf(__uint_as_float(r32_[0]), __uint_as_float(r32_[1]));
        }
        float mnew = mrun[qt];
        if (__any(mx > mrun[qt] + 6.f)) {
          mnew = fmaxf(mrun[qt], mx);
          const float alpha = __builtin_amdgcn_exp2f(mrun[qt] - mnew);
          mrun[qt] = mnew;
          lrun[qt] *= alpha;
#pragma unroll
          for (int dt = 0; dt < 4; ++dt)
#pragma unroll
            for (int r = 0; r < 4; ++r) O[dt][qt][r] *= alpha;
        }
        float ls = 0.f;
        float pv[16];
#pragma unroll
        for (int k4 = 0; k4 < 4; ++k4)
#pragma unroll
          for (int r = 0; r < 4; ++r) { float e = __builtin_amdgcn_exp2f(S[k4][qt][r] - mnew); pv[k4 * 4 + r] = e; ls += e; }
        lrun[qt] += ls;
#pragma unroll
        for (int kk = 0; kk < 2; ++kk) {
          typedef __attribute__((ext_vector_type(4))) unsigned u32x4;
          u32x4 w = {pack2(pv[kk * 8 + 0], pv[kk * 8 + 1]), pack2(pv[kk * 8 + 2], pv[kk * 8 + 3]),
                     pack2(pv[kk * 8 + 4], pv[kk * 8 + 5]), pack2(pv[kk * 8 + 6], pv[kk * 8 + 7])};
          pf[qt][kk] = __builtin_bit_cast(bf16x8, w);
        }
      }
#pragma unroll
      for (int kk = 0; kk < 2; ++kk)
#pragma unroll
        for (int dt = 0; dt < 4; ++dt) {
          typedef __attribute__((ext_vector_type(4))) unsigned u32x4;
          const u16* vp = sV + (dt * 16 + c) * VS + kk * 32 + g * 4;
          U2 lo = *(const U2*)vp, hi = *(const U2*)(vp + 16);
          u32x4 w = {lo.x, lo.y, hi.x, hi.y};
          bf16x8 vf = __builtin_bit_cast(bf16x8, w);
          O[dt][0] = __builtin_amdgcn_mfma_f32_16x16x32_bf16(vf, pf[0][kk], O[dt][0], 0, 0, 0);
          O[dt][1] = __builtin_amdgcn_mfma_f32_16x16x32_bf16(vf, pf[1][kk], O[dt][1], 0, 0, 0);
        }
    }
    const int b = bh >> 3, h = bh & 7;
#pragma unroll
    for (int qt = 0; qt < 2; ++qt) {
      float l = lrun[qt];
      l += __shfl_xor(l, 16); l += __shfl_xor(l, 32);
      const float inv = 1.f / l;
      const int s = qb * 128 + wave * 32 + qt * 16 + c;
      u16* dst = p.attn_out + ((size_t)(b * SEQ + s)) * 512 + h * 64;
#pragma unroll
      for (int dt = 0; dt < 4; ++dt) {
        U2 o; o.x = pack2(O[dt][qt][0] * inv, O[dt][qt][1] * inv); o.y = pack2(O[dt][qt][2] * inv, O[dt][qt][3] * inv);
        *(U2*)(dst + dt * 16 + g * 4) = o;
      }
    }
  }
  if (bid < (nb >> 1)) { for (int ch = bid; ch < 512; ch += nb) hyena_channel(p, smem, ch); }
}

__device__ __forceinline__ void phase4(const Params& p, unsigned char* smem, int bid, int nb) {
  const int tid = tidx(), lane = tid & 63, wave = __builtin_amdgcn_readfirstlane(tid >> 6);
  const int wm = wave >> 1, wn = wave & 1, c = lane & 15, g = lane >> 4;
  for (int it = bid; it < 1024; it += nb) {
    const int li_ = (it & 511) >> 3;
    const int m0 = (64 * (it >> 9) + 8 * (it & 7) + (li_ >> 3)) * 128, n0 = (li_ & 7) * 128;
    f32x4 acc[4][4];
#pragma unroll
    for (int i = 0; i < 4; ++i)
#pragma unroll
      for (int j = 0; j < 4; ++j) acc[i][j] = f32x4{0.f, 0.f, 0.f, 0.f};
    gemm_glds<128, 128, 2, 2, true>(p.attn_out, 512, p.w_oaT, 512, 512, m0, n0, smem, acc);
    const u16* gb = p.gates + (size_t)(m0 + wm * 64 + c) * 2048 + n0 + wn * 64 + g * 4;
#pragma unroll
    for (int mt = 0; mt < 4; ++mt)
#pragma unroll
      for (int nt = 0; nt < 4; ++nt) {
        const U2 ga = *(const U2*)(gb + (mt * 16) * 2048 + nt * 16);
        const U2 gh = *(const U2*)(gb + (mt * 16) * 2048 + nt * 16 + 1024);
        acc[mt][nt][0] *= bflo(ga.x) * __frcp_rn(bflo(gh.x));
        acc[mt][nt][1] *= bfhi(ga.x) * __frcp_rn(bfhi(gh.x));
        acc[mt][nt][2] *= bflo(ga.y) * __frcp_rn(bflo(gh.y));
        acc[mt][nt][3] *= bfhi(ga.y) * __frcp_rn(bfhi(gh.y));
      }
    gemm_glds_at<true>(p.yhT, T_TOK, p.w_ohT, 512, 512, m0, n0, smem, acc);
    u16* mb = p.merged + (size_t)(m0 + wm * 64 + c) * 1024 + n0 + wn * 64 + g * 4;
#pragma unroll
    for (int mt = 0; mt < 4; ++mt)
#pragma unroll
      for (int nt = 0; nt < 4; ++nt) {
        const U2 gh = *(const U2*)(gb + (mt * 16) * 2048 + nt * 16 + 1024);
        U2 o;
        o.x = pack2(acc[mt][nt][0] * bflo(gh.x), acc[mt][nt][1] * bfhi(gh.x));
        o.y = pack2(acc[mt][nt][2] * bflo(gh.y), acc[mt][nt][3] * bfhi(gh.y));
        *(U2*)(mb + (mt * 16) * 1024 + nt * 16) = o;
      }
  }
}

__device__ __forceinline__ void phase5(const Params& p, unsigned char* smem, int bid, int nb) {
  const int tid = tidx(), lane = tid & 63, wave = __builtin_amdgcn_readfirstlane(tid >> 6);
  const int wm = wave >> 1, wn = wave & 1, c = lane & 15, g = lane >> 4;
  for (int it = bid; it < 1024; it += nb) {
    const int li_ = (it & 511) >> 3;
    const int m0 = (64 * (it >> 9) + 8 * (it & 7) + (li_ >> 3)) * 128, n0 = (li_ & 7) * 128;
    f32x4 acc[4][4];
#pragma unroll
    for (int i = 0; i < 4; ++i)
#pragma unroll
      for (int j = 0; j < 4; ++j) acc[i][j] = f32x4{0.f, 0.f, 0.f, 0.f};
    gemm_glds<128, 128, 2, 2, true>(p.merged, 1024, p.w_outT, 1024, 1024, m0, n0, smem, acc);
#pragma unroll
    for (int mt = 0; mt < 4; ++mt) {
      const int t = m0 + wm * 64 + mt * 16 + c;
      float ss = 0.f;
#pragma unroll
      for (int nt = 0; nt < 4; ++nt) {
        const int n = n0 + wn * 64 + nt * 16 + g * 4;
        const F4 xv = *(const F4*)(p.x + (size_t)t * 1024 + n);
        const F4 gn = *(const F4*)(p.ffn_norm + n);
        F4 h1;
        h1.x = xv.x + acc[mt][nt][0]; h1.y = xv.y + acc[mt][nt][1]; h1.z = xv.z + acc[mt][nt][2]; h1.w = xv.w + acc[mt][nt][3];
        *(F4*)(p.out + (size_t)t * 1024 + n) = h1;
        U2 o; o.x = pack2(h1.x * gn.x, h1.y * gn.y); o.y = pack2(h1.z * gn.z, h1.w * gn.w);
        *(U2*)(p.hb + (size_t)t * 1024 + n) = o;
        ss += h1.x * h1.x + h1.y * h1.y + h1.z * h1.z + h1.w * h1.w;
      }
      ss += __shfl_xor(ss, 16); ss += __shfl_xor(ss, 32);
      if (g == 0) p.ssq2[t * 16 + (n0 >> 6) + wn] = ss;
    }
  }
}

#define KEY_INSERT(xk)                                                               \
  {                                                                                  \
    float x_ = (xk);                                                                 \
    _Pragma("unroll") for (int k_ = 0; k_ < 16; ++k_) {                              \
      const float hi_ = fmaxf(tv[k_], x_); x_ = fminf(tv[k_], x_); tv[k_] = hi_;    \
    }                                                                                \
  }

__device__ __forceinline__ void phase6(const Params& p, unsigned char* smem, int bid, int nb) {
  float* sc = (float*)smem;
  float* rsl = (float*)(smem + OFF_RS);
  const int tid = tidx(), lane = tid & 63, wave = __builtin_amdgcn_readfirstlane(tid >> 6), c = lane & 15, g = lane >> 4;
  const int wm = wave >> 1, wn = wave & 1;
  if (bid >= (nb >> 1)) { ph_expert_fp8(p.eu, p.eu8, p.eus, bid, nb); ph_expert_fp8(p.ev, p.ev8, p.evs, bid, nb); }
  for (int it = bid; it < 2048; it += nb) {
    const int li_ = (it & 511) >> 3;
    const int hs = li_ & 15, m0 = (32 * (it >> 9) + 4 * (it & 7) + (li_ >> 4)) * 128;
    __syncthreads();
    if (tid < 128) {
      const float* sq = p.ssq2 + (size_t)(m0 + tid) * 16;
      float s = 0.f;
#pragma unroll
      for (int i = 0; i < 16; ++i) s += sq[i];
      rsl[tid] = rsqrtf(s * (1.f / 1024.f) + EPS);
    }
    f32x4 acc[4][4];
#pragma unroll
    for (int i = 0; i < 4; ++i)
#pragma unroll
      for (int j = 0; j < 4; ++j) acc[i][j] = f32x4{0.f, 0.f, 0.f, 0.f};
    gemm_glds<128, 128, 2, 2>(p.hb, 1024, p.wcT, 1024, 1024, m0, hs * 128, smem, acc);
#pragma unroll
    for (int mt = 0; mt < 4; ++mt)
#pragma unroll
      for (int r = 0; r < 4; ++r) {
        const int rl = wm * 64 + mt * 16 + g * 4 + r;
        const float rstd = rsl[rl];
#pragma unroll
        for (int nt = 0; nt < 4; ++nt) {
          const int col = wn * 64 + nt * 16 + c;
          const unsigned kb = (__float_as_uint(acc[mt][nt][r] * rstd) & 0xffffff80u) | (unsigned)col;
          sc[rl * 129 + col] = __uint_as_float(kb);
        }
      }
    __syncthreads();
    float tv[16];
    const int row = tid & 127;
    float* seg = sc + row * 129 + (tid >> 7) * 64;
#pragma unroll
    for (int k = 0; k < 16; ++k) tv[k] = -3.0e38f;
#pragma unroll 8
    for (int j = 0; j < 64; ++j) { KEY_INSERT(seg[j]) }
    if (tid >= 128) {
#pragma unroll
      for (int k = 0; k < 16; ++k) seg[k] = tv[k];
    }
    __syncthreads();
    if (tid < 128) {
#pragma unroll
      for (int k = 0; k < 16; ++k) tv[k] = fmaxf(tv[k], seg[64 + 15 - k]);
#pragma unroll
      for (int st = 8; st > 0; st >>= 1)
#pragma unroll
        for (int k = 0; k < 16; ++k)
          if ((k & st) == 0) { const float hi = fmaxf(tv[k], tv[k + st]), lo = fminf(tv[k], tv[k + st]); tv[k] = hi; tv[k + st] = lo; }
      F4* dst = (F4*)(p.tk + ((size_t)(m0 + row) * 16 + hs) * 16);
      dst[0] = F4{tv[0], tv[1], tv[2], tv[3]}; dst[1] = F4{tv[4], tv[5], tv[6], tv[7]};
      dst[2] = F4{tv[8], tv[9], tv[10], tv[11]}; dst[3] = F4{tv[12], tv[13], tv[14], tv[15]};
    }
  }
  if (bid < (nb >> 1)) { ph_expert_fp8(p.eu, p.eu8, p.eus, bid, nb); ph_expert_fp8(p.ev, p.ev8, p.evs, bid, nb); }
}

__device__ __forceinline__ void combine_task(const Params& p, int task, int* oi, float* og) {
  const float* s1 = p.tk + (size_t)task * 32; const float* s2 = s1 + 16;
  float v1[16], v2[16];
#pragma unroll
  for (int k4 = 0; k4 < 4; ++k4) {
    const F4 a = ((const F4*)s1)[k4], b = ((const F4*)s2)[k4];
    v1[4 * k4] = a.x; v1[4 * k4 + 1] = a.y; v1[4 * k4 + 2] = a.z; v1[4 * k4 + 3] = a.w;
    v2[4 * k4] = b.x; v2[4 * k4 + 1] = b.y; v2[4 * k4 + 2] = b.z; v2[4 * k4 + 3] = b.w;
  }
  float tv[16];
#pragma unroll
  for (int k = 0; k < 16; ++k) tv[k] = -3.0e38f;
#pragma unroll
  for (int a = 0; a < 16; ++a)
#pragma unroll
    for (int b = 0; b < 16; ++b)
      if ((a + 1) * (b + 1) <= 16) {
        const unsigned kb = (__float_as_uint(v1[a] + v2[b]) & 0xffffff00u) | (unsigned)(a * 16 + b);
        KEY_INSERT(__uint_as_float(kb))
      }
  float es[16]; float sum = 0.f;
#pragma unroll
  for (int k = 0; k < 16; ++k) { es[k] = __expf(tv[k] - tv[0]); sum += es[k]; }
  const float inv = 1.f / sum;
#pragma unroll
  for (int k = 0; k < 16; ++k) {
    const unsigned ab = __float_as_uint(tv[k]) & 0xffu;
    const int a = ab >> 4, b = ab & 15;
    oi[k] = (int)(__float_as_uint(s1[a]) & 127u) * 128 + (int)(__float_as_uint(s2[b]) & 127u);
    og[k] = es[k] * inv;
  }
}
__device__ __forceinline__ void phase6b(const Params& p, int bid, int nb) {
  for (int task = bid * 256 + tidx(); task < T_TOK * 8; task += nb * 256)
    combine_task(p, task, p.sel_idx + (size_t)task * 16, p.sel_g + (size_t)task * 16);
}

__device__ __forceinline__ void unpack8(U4 v, float* f) {
  f[0] = bflo(v.x); f[1] = bfhi(v.x); f[2] = bflo(v.y); f[3] = bfhi(v.y);
  f[4] = bflo(v.z); f[5] = bfhi(v.z); f[6] = bflo(v.w); f[7] = bfhi(v.w);
}

__device__ __forceinline__ float dot16_fp8(U4 r, const float* hv) {
  f32x2 s2 = {0.f, 0.f};
#pragma unroll
  for (int k = 0; k < 4; ++k) {
    const f32x2 a = __builtin_amdgcn_cvt_pk_f32_fp8((int)r[k], false), b = __builtin_amdgcn_cvt_pk_f32_fp8((int)r[k], true);
    const f32x2 h0 = {hv[4 * k], hv[4 * k + 1]}, h1 = {hv[4 * k + 2], hv[4 * k + 3]};
    s2 = __builtin_elementwise_fma(a, h0, s2);
    s2 = __builtin_elementwise_fma(b, h1, s2);
  }
  return s2.x + s2.y;
}
__device__ __forceinline__ void axpy16_fp8(U4 r, float w, float* acc) {
  const f32x2 w2 = {w, w};
#pragma unroll
  for (int k = 0; k < 4; ++k) {
    const f32x2 a = __builtin_amdgcn_cvt_pk_f32_fp8((int)r[k], false), b = __builtin_amdgcn_cvt_pk_f32_fp8((int)r[k], true);
    f32x2 c0 = {acc[4 * k], acc[4 * k + 1]}, c1 = {acc[4 * k + 2], acc[4 * k + 3]};
    c0 = __builtin_elementwise_fma(w2, a, c0);
    c1 = __builtin_elementwise_fma(w2, b, c1);
    acc[4 * k] = c0.x; acc[4 * k + 1] = c0.y; acc[4 * k + 2] = c1.x; acc[4 * k + 3] = c1.y;
  }
}
#define P7_LOAD(dst, tab, bidx)                                                               \
  _Pragma("unroll") for (int j_ = 0; j_ < 8; ++j_) {                                          \
    const int e_ = (bidx) * 8 + j_;                                                           \
    const int id_ = __builtin_amdgcn_readlane((e_ < 64) ? id0 : id1, e_ & 63);                \
    dst[j_] = *(const U4*)((tab) + (size_t)id_ * 1024 + lane * 16);                           \
  }
#define P7_ACT(src, bidx)                                                                     \
  {                                                                                           \
    float d_[8];                                                                              \
    _Pragma("unroll") for (int j_ = 0; j_ < 8; ++j_) d_[j_] = dot16_fp8(src[j_], hv);         \
    float r1_[4], r2_[2];                                                                     \
    _Pragma("unroll") for (int k_ = 0; k_ < 4; ++k_) {                                        \
      const float keep_ = (lane & 32) ? d_[2 * k_ + 1] : d_[2 * k_];                          \
      const float send_ = (lane & 32) ? d_[2 * k_] : d_[2 * k_ + 1];                          \
      r1_[k_] = keep_ + __shfl_xor(send_, 32);                                                \
    }                                                                                         \
    _Pragma("unroll") for (int k_ = 0; k_ < 2; ++k_) {                                        \
      const float keep_ = (lane & 16) ? r1_[2 * k_ + 1] : r1_[2 * k_];                        \
      const float send_ = (lane & 16) ? r1_[2 * k_] : r1_[2 * k_ + 1];                        \
      r2_[k_] = keep_ + __shfl_xor(send_, 16);                                                \
    }                                                                                         \
    float r3_;                                                                                \
    {                                                                                         \
      const float keep_ = (lane & 8) ? r2_[1] : r2_[0];                                       \
      const float send_ = (lane & 8) ? r2_[0] : r2_[1];                                       \
      r3_ = keep_ + __shfl_xor(send_, 8);                                                     \
    }                                                                                         \
    r3_ += __shfl_xor(r3_, 4); r3_ += __shfl_xor(r3_, 2); r3_ += __shfl_xor(r3_, 1);          \
    if ((lane & 7) == 0) wl[(bidx) * 8 + jl] = r3_;                                           \
  }
#define P7_ACC(src, bidx)                                                                     \
  {                                                                                           \
    const F4 wa_ = *(const F4*)(wl + (bidx) * 8), wb_ = *(const F4*)(wl + (bidx) * 8 + 4);    \
    axpy16_fp8(src[0], wa_.x, acc); axpy16_fp8(src[1], wa_.y, acc);                           \
    axpy16_fp8(src[2], wa_.z, acc); axpy16_fp8(src[3], wa_.w, acc);                           \
    axpy16_fp8(src[4], wb_.x, acc); axpy16_fp8(src[5], wb_.y, acc);                           \
    axpy16_fp8(src[6], wb_.z, acc); axpy16_fp8(src[7], wb_.w, acc);                           \
  }

__device__ __forceinline__ void sort128(int& r0, int& r1, int lane) {
#pragma unroll
  for (int k = 2; k <= 128; k <<= 1) {
#pragma unroll
    for (int j = k >> 1; j > 0; j >>= 1) {
      if (j == 64) { const int lo = min(r0, r1), hi = max(r0, r1); r0 = lo; r1 = hi; }
      else {
        const bool lower = (lane & j) == 0;
        { const int pv = __shfl_xor(r0, j); const bool asc = (k == 128) || ((lane & k) == 0); r0 = (lower == asc) ? min(r0, pv) : max(r0, pv); }
        { const int pv = __shfl_xor(r1, j); const bool asc = (k == 128) || (((64 + lane) & k) == 0); r1 = (lower == asc) ? min(r1, pv) : max(r1, pv); }
      }
    }
  }
}

__device__ __forceinline__ void phase7(const Params& p, unsigned char* smem, int bid, int nb, float* outp, bool fused) {
  const int tid = tidx(), lane = tid & 63, wave = __builtin_amdgcn_readfirstlane(tid >> 6);
  float* wl0 = (float*)smem + wave * 2048;
  int* sidl0 = (int*)smem + 8192 + wave * 2048;
  const int jl = ((lane >> 3) & 1) * 4 + ((lane >> 4) & 1) * 2 + ((lane >> 5) & 1);
  const int tstep = nb * 4;
  int* selI = sidl0 + 1024; float* selG = wl0 + 1024;
  if (fused) {
    const int t = bid * 4 + wave + (lane >> 3) * tstep;
    if (t < T_TOK) combine_task(p, t * 8 + (lane & 7), selI + lane * 16, selG + lane * 16);
  }
  {
    int k = 0;
#pragma unroll 1
    for (int t = bid * 4 + wave; t < T_TOK; t += tstep, ++k) {
      float* wl = wl0 + k * 128;
      const U4* hr = (const U4*)(p.hb + (size_t)t * 1024 + lane * 16);
      float hv[16];
      unpack8(hr[0], hv); unpack8(hr[1], hv + 8);
      float s = 0.f;
#pragma unroll
      for (int i = 0; i < 16; ++i) s += p.ssq2[(size_t)t * 16 + i];
      const float rstd = rsqrtf(s * (1.f / 1024.f) + EPS);
      int k0 = ((fused ? selI[k * 128 + lane] : p.sel_idx[(size_t)t * 128 + lane]) << 7) | lane;
      int k1 = ((fused ? selI[k * 128 + 64 + lane] : p.sel_idx[(size_t)t * 128 + 64 + lane]) << 7) | (64 + lane);
      sort128(k0, k1, lane);
      const int id0 = k0 >> 7, id1 = k1 >> 7;
      sidl0[k * 128 + lane] = id0; sidl0[k * 128 + 64 + lane] = id1;
      const float us0 = p.eus[id0] * rstd, us1 = p.eus[id1] * rstd;
      const float gv0 = (fused ? selG[k * 128 + (k0 & 127)] : p.sel_g[(size_t)t * 128 + (k0 & 127)]) * p.evs[id0];
      const float gv1 = (fused ? selG[k * 128 + (k1 & 127)] : p.sel_g[(size_t)t * 128 + (k1 & 127)]) * p.evs[id1];
      U4 ba[8], bb[8], bc[8];
      P7_LOAD(ba, p.eu8, 0)
      P7_LOAD(bb, p.eu8, 1)
#pragma unroll 1
      for (int b = 0; b < 15; b += 3) {
        const int b3 = (b + 3 < 15) ? b + 3 : 15, b4 = (b + 4 < 15) ? b + 4 : 15;
        P7_LOAD(bc, p.eu8, b + 2)
        P7_ACT(ba, b)
        P7_LOAD(ba, p.eu8, b3)
        P7_ACT(bb, b + 1)
        P7_LOAD(bb, p.eu8, b4)
        P7_ACT(bc, b + 2)
      }
      P7_ACT(ba, 15)
      {
        const float x0 = wl[lane] * us0, x1 = wl[64 + lane] * us1;
        wl[lane] = gv0 * 0.5f * x0 * (1.f + erff(x0 * 0.70710678118654752f));
        wl[64 + lane] = gv1 * 0.5f * x1 * (1.f + erff(x1 * 0.70710678118654752f));
      }
    }
  }
#define P7B_LOAD(dst, bidx)                                                                    \
  _Pragma("unroll") for (int j_ = 0; j_ < 32; ++j_) {                                          \
    const int e_ = (bidx) * 32 + j_;                                                           \
    const int id_ = __builtin_amdgcn_readlane(((bidx) < 2) ? id0 : id1, e_ & 63);              \
    dst[j_] = *(const unsigned*)(vb + (size_t)id_ * 1024);                                     \
  }
#define P7B_ACC(src, bidx)                                                                     \
  _Pragma("unroll") for (int j4_ = 0; j4_ < 8; ++j4_) {                                        \
    const F4 w4_ = *(const F4*)(wl + (bidx) * 32 + j4_ * 4);                                   \
    _Pragma("unroll") for (int jj_ = 0; jj_ < 4; ++jj_) {                                      \
      const float ws_ = w4_[jj_];                                                              \
      const f32x2 w2_ = {ws_, ws_};                                                            \
      const int r_ = (int)src[j4_ * 4 + jj_];                                                  \
      a01 = __builtin_elementwise_fma(w2_, __builtin_amdgcn_cvt_pk_f32_fp8(r_, false), a01);   \
      a23 = __builtin_elementwise_fma(w2_, __builtin_amdgcn_cvt_pk_f32_fp8(r_, true), a23);    \
    }                                                                                          \
  }
#pragma unroll 1
  for (int q = 0; q < 4; ++q) {
    const unsigned char* vb = p.ev8 + q * 256 + lane * 4;
    int k = 0;
#pragma unroll 1
    for (int t = bid * 4 + wave; t < T_TOK; t += tstep, ++k) {
      const float* wl = wl0 + k * 128;
      const int id0 = sidl0[k * 128 + lane], id1 = sidl0[k * 128 + 64 + lane];
      unsigned ra[32], rb[32], rc[32];
      f32x2 a01 = {0.f, 0.f}, a23 = {0.f, 0.f};
      P7B_LOAD(ra, 0)
      P7B_LOAD(rb, 1)
      P7B_LOAD(rc, 2)
      P7B_ACC(ra, 0)
      P7B_LOAD(ra, 3)
      P7B_ACC(rb, 1)
      P7B_ACC(rc, 2)
      P7B_ACC(ra, 3)
      F4* o = (F4*)(outp + (size_t)t * 1024 + q * 256 + lane * 4);
      F4 v = *o;
      v.x += a01.x; v.y += a01.y; v.z += a23.x; v.w += a23.y;
      *o = v;
    }
  }
#undef P7B_LOAD
#undef P7B_ACC
}

__device__ __forceinline__ void run_phase(int ph, const Params& p, unsigned char* smem, int bid, int nb) {
#ifdef ONLY_PHASE
  if (ph != ONLY_PHASE) return;
#endif
  switch (ph) {
    case 0: phase0(p, smem, lbid(), nb); break;
    case 1: phase1<0>(p, smem, lbid(), nb); break;
    case 2: phase1<1>(p, smem, lbid(), nb); break;
    case 3: phase3(p, smem, lbid(), nb); break;
    case 4: phase4(p, smem, lbid(), nb); break;
    case 5: phase5(p, smem, lbid(), nb); break;
    case 6: phase6(p, smem, lbid(), nb); break;
    default: phase7(p, smem, lbid(), nb, p.out, false); break;
  }
}

__global__ void __launch_bounds__(256, 2) mega_kernel(Params p) {
  __shared__ __attribute__((aligned(16))) unsigned char smem[SMEM_BYTES];
  __shared__ U4 xb_words;
  cg::grid_group grid = cg::this_grid();
  const int bid = blockIdx.x, nb = gridDim.x;
  if (tidx() == 0) xb_words = U4{0u, 0u, 0u, 0u};
  __syncthreads();
  (void)xcd_barrier_post(p.bar, (volatile LAS unsigned*)&xb_words);
#define XBAR() do { XcdBarrier xb_; xb_.bar = p.bar; xb_.x = xb_xcc_id(); xb_.st = (volatile LAS unsigned*)&xb_words; xcd_barrier(xb_); } while (0)
#ifdef ONLY_PHASE
  run_phase(ONLY_PHASE, p, smem, bid, nb);
  grid.sync();
  XBAR();
#else
#ifndef DUP_PHASE
#define DUP_PHASE -1
#endif
#define DUP(k, call) if (DUP_PHASE == k) { call; XBAR(); }
  phase0(p, smem, lbid(), nb);
  if (p.use_cg) grid.sync();
  XBAR();
  DUP(0, phase0(p, smem, lbid(), nb))
  phase1<0>(p, smem, lbid(), nb); XBAR();
  DUP(1, phase1<1>(p, smem, lbid(), nb))
  phase1<1>(p, smem, lbid(), nb); XBAR();
  DUP(3, phase3(p, smem, lbid(), nb))
  phase3(p, smem, lbid(), nb); XBAR();
  DUP(4, phase4(p, smem, lbid(), nb))
  phase4(p, smem, lbid(), nb); XBAR();
  DUP(5, phase5(p, smem, lbid(), nb))
  phase5(p, smem, lbid(), nb); XBAR();
  DUP(6, phase6(p, smem, lbid(), nb))
  phase6(p, smem, lbid(), nb); XBAR();
  const bool fuse6b = (nb * 32 >= T_TOK);
  if (!fuse6b) { phase6b(p, lbid(), nb); XBAR(); }
  DUP(7, phase7(p, smem, lbid(), nb, (float*)p.K, fuse6b))
  phase7(p, smem, lbid(), nb, p.out, fuse6b);
#endif
}

#if MULTI_LAUNCH
__global__ void __launch_bounds__(256, 2) phase_kernel(Params p, int ph) {
  __shared__ __attribute__((aligned(16))) unsigned char smem[SMEM_BYTES];
  run_phase(ph, p, smem, blockIdx.x, gridDim.x);
}
#endif

extern "C" void kernel_launch(void* const* d_in, const int* in_sizes, int n_in, void* d_out, int out_size, void* d_ws,
                              size_t ws_size, hipStream_t stream) {
  (void)in_sizes; (void)n_in; (void)out_size;
  Params p{};
  const float** fp = (const float**)&p;
  for (int i = 0; i < 31; ++i) fp[i] = (const float*)d_in[i];
  p.out = (float*)d_out;
  unsigned char* w = (unsigned char*)d_ws;
  const size_t MB = 1024 * 1024;
  size_t off = 0;
  unsigned char* R1 = w + off; off += 64 * MB;
  unsigned char* R2 = w + off; off += 48 * MB;
  unsigned char* R3 = w + off; off += 32 * MB;
  unsigned char* R4 = w + off; off += 24 * MB;
  unsigned char* R5 = w + off; off += 16 * MB;
  unsigned char* R6 = w + off; off += 16 * MB;
  unsigned char* R7 = w + off; off += 24 * MB;
  auto take = [&](size_t bytes) { unsigned char* q = w + off; off += (bytes + 255) & ~(size_t)255; return q; };
  p.gates = (u16*)R1; p.eub = (u16*)R1; p.evb = (u16*)(R1 + 32 * MB); p.eu8 = R1; p.ev8 = R1 + 16 * MB;
  p.uT = (u16*)R2; p.merged = (u16*)R4; p.sel_idx = (int*)(R2 + 32 * MB); p.sel_g = (float*)(R2 + 40 * MB);
  p.xb = (u16*)R3; p.Q = (u16*)R7; p.hb = (u16*)R3;
  p.K = (u16*)R4; p.Vt = (u16*)R5;
  p.cq = (u16*)R6; p.ckv = (u16*)(R6 + 8 * MB); p.attn_out = (u16*)R6; p.tk = (float*)R6;
  p.yhT = (u16*)R3;
  p.w_inT = (u16*)take((size_t)4096 * 1024 * 2);
  p.w_uqT = (u16*)take((size_t)768 * 256 * 2);
  p.w_ukvT = (u16*)take((size_t)1024 * 128 * 2);
  p.w_oaT = (u16*)take((size_t)1024 * 512 * 2);
  p.w_ohT = (u16*)take((size_t)1024 * 512 * 2);
  p.w_outT = (u16*)take((size_t)1024 * 1024 * 2);
  p.wqb = (u16*)take((size_t)1024 * 2048 * 2);
  p.keysb = (u16*)take((size_t)2 * 8 * 128 * 128 * 2);
  p.wcT = (u16*)take((size_t)2048 * 1024 * 2);
  p.h3 = (float*)take((size_t)2048 * 64 * 4);
  p.rstd1 = (float*)take((size_t)T_TOK * 4);
  p.ssq2 = (float*)take((size_t)T_TOK * 16 * 4);
  p.bar = (unsigned*)take((size_t)XCD_BAR_WORDS * 4);
  p.eus = (float*)take((size_t)16384 * 4);
  p.filt = (u16*)take((size_t)1024 * 2048 * 2);
  p.use_cg = 0; p.pad_ = 0;
  p.evs = (float*)take((size_t)16384 * 4);
  if (off > ws_size) { fprintf(stderr, "workspace too small: need %zu have %zu\n", off, ws_size); return; }

  (void)hipMemsetAsync(p.bar, 0, (size_t)XCD_BAR_WORDS * 4, stream);
#if MULTI_LAUNCH
  for (int ph = 0; ph < 8; ++ph) phase_kernel<<<dim3(512), dim3(256), 0, stream>>>(p, ph);
#else
  static int grid_blocks = 0;
  if (!grid_blocks) {
    int dev = 0, cus = 0, per_cu = 0;
    (void)hipGetDevice(&dev);
    (void)hipDeviceGetAttribute(&cus, hipDeviceAttributeMultiprocessorCount, dev);
    (void)hipOccupancyMaxActiveBlocksPerMultiprocessor(&per_cu, mega_kernel, 256, 0);
    if (per_cu > 2) per_cu = 2;
    if (per_cu < 1) per_cu = 1;
    grid_blocks = cus * per_cu;
  }
  void* args[] = {&p};
  hipError_t e = hipLaunchCooperativeKernel((void*)mega_kernel, dim3(grid_blocks), dim3(256), args, 0, stream);
  if (e != hipSuccess) fprintf(stderr, "cooperative launch failed: %s (grid %d)\n", hipGetErrorString(e), grid_blocks);
#endif
}
```

```cpp
#include <hip/hip_runtime.h>
#include <hip/hip_cooperative_groups.h>
#include <cstdio>
#include <cstdint>
namespace cg = cooperative_groups;

#ifndef MULTI_LAUNCH
#define MULTI_LAUNCH 0
#endif

typedef unsigned short u16;
typedef __attribute__((ext_vector_type(8))) short bf16x8;
typedef __attribute__((ext_vector_type(4))) float f32x4;
typedef __attribute__((ext_vector_type(16))) float f32x16;
typedef __attribute__((ext_vector_type(4))) unsigned U4;
typedef __attribute__((ext_vector_type(2))) unsigned U2;
typedef __attribute__((ext_vector_type(4))) float F4;

constexpr int T_TOK = 16384;
constexpr int SEQ = 2048;
constexpr float EPS = 1e-6f;
constexpr int SMEM_BYTES = 72192;
constexpr int OFF_SB = 34816;
constexpr int OFF_RS = 71680;
constexpr int ZS = 2248;

struct Params {
  const float *x, *attn_norm, *w_in, *b_gate, *q_a_norm, *w_uq, *kv_a_norm, *w_ukv, *q_norm, *k_norm, *w_o_attn,
      *conv_w, *conv_b, *fw1, *fb1, *fw2, *fb2, *fw3, *fb3, *fw4, *fb4, *ffreq, *hbias, *w_o_hyena, *w_out, *ffn_norm,
      *peer_wq, *keys1, *keys2, *eu, *ev;
  float* out;
  u16 *xb, *w_inT, *w_uqT, *w_ukvT, *w_oaT, *w_ohT, *w_outT, *wqb, *keysb, *wcT, *eub, *evb;
  u16 *cq, *ckv, *uT, *gates, *Q, *K, *Vt, *attn_out, *yhT, *merged, *hb;
  float *h3, *rstd1, *ssq2, *sel_g;
  int* sel_idx;
  unsigned* bar;
  unsigned char *eu8, *ev8;
  float *eus, *evs;
  u16* filt;
  float* tk;
  int use_cg; int pad_;
};

typedef __bf16 bf16x2_t __attribute__((ext_vector_type(2)));
typedef float f32x2_t __attribute__((ext_vector_type(2)));
__device__ __forceinline__ unsigned pack2(float a, float b) {
  const f32x2_t v = {a, b};
  return __builtin_bit_cast(unsigned, __builtin_convertvector(v, bf16x2_t));
}
__device__ __forceinline__ u16 f2bf(float f) { return (u16)(pack2(f, 0.f) & 0xffffu); }
__device__ __forceinline__ int tidx() { int t = threadIdx.x; asm volatile("" : "+v"(t)); return t; }
__device__ __forceinline__ int lbid() { int b = blockIdx.x; asm volatile("" : "+s"(b)); return b; }
__device__ __forceinline__ float bf2f(u16 h) { return __uint_as_float(((unsigned)h) << 16); }
__device__ __forceinline__ float bflo(unsigned w) { return __uint_as_float(w << 16); }
__device__ __forceinline__ float bfhi(unsigned w) { return __uint_as_float(w & 0xffff0000u); }
__device__ __forceinline__ float wave_sum(float v) {
#pragma unroll
  for (int o = 32; o > 0; o >>= 1) v += __shfl_xor(v, o);
  return v;
}
__device__ __forceinline__ float sum16(float v) {
  v += __shfl_xor(v, 1); v += __shfl_xor(v, 2); v += __shfl_xor(v, 4); v += __shfl_xor(v, 8);
  return v;
}


#define XB_TMO      128
#define XB_XCNT(j)  (256  + 64 * (j))
#define XB_XSUB(j)  (1280 + 64 * (j))
#define XB_XGEN(j)  (2304 + 64 * (j))
#define XB_TOP      3328
#define XB_TOPGEN   3392
#define XCD_BAR_WORDS 3456
#define XB_SPIN_CAP (1u << 22)
#define LAS __attribute__((address_space(3)))
__device__ __forceinline__ unsigned xb_ld(unsigned* p)              { return __hip_atomic_load(p, __ATOMIC_RELAXED, __HIP_MEMORY_SCOPE_AGENT); }
__device__ __forceinline__ unsigned xb_add(unsigned* p, unsigned v) { return __hip_atomic_fetch_add(p, v, __ATOMIC_RELAXED, __HIP_MEMORY_SCOPE_AGENT); }
__device__ __forceinline__ unsigned xb_xcc_id() { return (unsigned)__builtin_amdgcn_s_getreg((3 << 11) | 20) & 0xFu; }
#define XB_SPIN(cond, bar) do { unsigned _sp = 0; while (cond) { __builtin_amdgcn_s_sleep(1); \
    if ((++_sp & 255u) == 0u) { if (xb_ld(&(bar)[XB_TMO])) break; if (_sp > XB_SPIN_CAP) { atomicAdd(&(bar)[XB_TMO], 1u); break; } } } } while (0)
struct XcdBarrier { unsigned* bar; unsigned x; volatile LAS unsigned* st; };
__device__ __forceinline__ XcdBarrier xcd_barrier_post(unsigned* bar, volatile LAS unsigned* st) {
  XcdBarrier b; b.bar = bar; b.x = xb_xcc_id(); b.st = st;
  if (threadIdx.x == 0) (void)xb_add(&bar[XB_XCNT(b.x)], 1u);
  return b;
}
__device__ __forceinline__ void xcd_barrier_complete(unsigned* bar, unsigned x, unsigned& nloc, unsigned& nx) {
  const unsigned G = gridDim.x * gridDim.y * gridDim.z;
  unsigned sum, cnt, mine, sp = 0u;
  for (;;) {
    sum = 0u; cnt = 0u; mine = 0u;
#pragma unroll
    for (unsigned j = 0; j < 16; ++j) { const unsigned c = xb_ld(&bar[XB_XCNT(j)]); sum += c; cnt += (c > 0u) ? 1u : 0u; mine = (j == x) ? c : mine; }
    if (sum == G) break;
    __builtin_amdgcn_s_sleep(1);
    if ((++sp & 255u) == 0u) { if (xb_ld(&bar[XB_TMO])) break; if (sp > XB_SPIN_CAP) { atomicAdd(&bar[XB_TMO], 1u); break; } }
  }
  nloc = mine > 0u ? mine : 1u; nx = cnt > 0u ? cnt : 1u;
}
__device__ __forceinline__ void xcd_barrier(const XcdBarrier& b) {
  asm volatile("s_waitcnt vmcnt(0)" ::: "memory");
  __syncthreads();
  if (threadIdx.x == 0) {
    unsigned* bar = b.bar;
    __builtin_amdgcn_s_waitcnt(0);
    unsigned nloc = b.st[0], nx = b.st[1];
    if (nloc == 0u) { xcd_barrier_complete(bar, b.x, nloc, nx); b.st[0] = nloc; b.st[1] = nx; }
    const unsigned old = xb_add(&bar[XB_XSUB(b.x)], 1u);
    const unsigned gen = old / nloc;
    if (old + 1u == (gen + 1u) * nloc) {
      __builtin_amdgcn_fence(__ATOMIC_RELEASE, "agent");
      asm volatile("s_waitcnt vmcnt(0)" ::: "memory");
      const unsigned og = xb_add(&bar[XB_TOP], 1u);
      const unsigned tg = og / nx;
      if (og + 1u == (tg + 1u) * nx) xb_add(&bar[XB_TOPGEN], 1u);
      else XB_SPIN(xb_ld(&bar[XB_TOPGEN]) == tg, bar);
      __builtin_amdgcn_fence(__ATOMIC_ACQUIRE, "agent");
      xb_add(&bar[XB_XGEN(b.x)], 1u);
      asm volatile("s_waitcnt vmcnt(0)" ::: "memory");
    } else {
      XB_SPIN(xb_ld(&bar[XB_XGEN(b.x)]) == gen, bar);
      __builtin_amdgcn_fence(__ATOMIC_ACQUIRE, "agent");
      asm volatile("s_waitcnt vmcnt(0)" ::: "memory");
    }
  }
  __syncthreads();
}

template <int BM, int BN, int WM, int WN, bool ATRANS, int BK>
__device__ __forceinline__ void gemm_main(const u16* A, int lda, const u16* Bt, int ldb, int K, int m0, int n0,
                                          u16* sA, u16* sB, f32x4 (&acc)[BM / WM / 16][BN / WN / 16]) {
  constexpr int MT = BM / WM / 16, NTL = BN / WN / 16;
  constexpr int CPR = BK / 8;
  constexpr int LDK = BK + 8;
  constexpr int ACH = BM * CPR / 256, BCH = BN * CPR / 256;
  const int tid = tidx(), lane = tid & 63, wave = __builtin_amdgcn_readfirstlane(tid >> 6);
  const int wm = wave / WN, wn = wave % WN;
  const int c = lane & 15, g = lane >> 4;
  U4 ra[ACH], rb[BCH];
  const int nk = K / BK;
  const int krot = (int)((unsigned)(blockIdx.x >> 3) % (unsigned)nk);
#pragma unroll
  for (int i = 0; i < ACH; ++i) {
    int ch = tid + i * 256;
    if (!ATRANS) { int row = ch / CPR, kc = ch % CPR; ra[i] = *(const U4*)(A + (size_t)(m0 + row) * lda + krot * BK + kc * 8); }
    else { int k = ch / (BM / 8), mc = ch % (BM / 8); ra[i] = *(const U4*)(A + (size_t)(krot * BK + k) * lda + m0 + mc * 8); }
  }
#pragma unroll
  for (int i = 0; i < BCH; ++i) {
    int ch = tid + i * 256; int row = ch / CPR, kc = ch % CPR;
    rb[i] = *(const U4*)(Bt + (size_t)(n0 + row) * ldb + krot * BK + kc * 8);
  }
  for (int kt = 0; kt < nk; ++kt) {
    __syncthreads();
#pragma unroll
    for (int i = 0; i < ACH; ++i) {
      int ch = tid + i * 256;
      if (!ATRANS) { int row = ch / CPR, kc = ch % CPR; *(U4*)(sA + row * LDK + kc * 8) = ra[i]; }
      else {
        int k = ch / (BM / 8), mc = ch % (BM / 8);
        u16* d = sA + (mc * 8) * LDK + k;
        d[0 * LDK] = (u16)(ra[i].x & 0xffff); d[1 * LDK] = (u16)(ra[i].x >> 16);
        d[2 * LDK] = (u16)(ra[i].y & 0xffff); d[3 * LDK] = (u16)(ra[i].y >> 16);
        d[4 * LDK] = (u16)(ra[i].z & 0xffff); d[5 * LDK] = (u16)(ra[i].z >> 16);
        d[6 * LDK] = (u16)(ra[i].w & 0xffff); d[7 * LDK] = (u16)(ra[i].w >> 16);
      }
    }
#pragma unroll
    for (int i = 0; i < BCH; ++i) {
      int ch = tid + i * 256; int row = ch / CPR, kc = ch % CPR;
      *(U4*)(sB + row * LDK + kc * 8) = rb[i];
    }
    __syncthreads();
    if (kt + 1 < nk) {
      int kn = kt + 1 + krot; if (kn >= nk) kn -= nk;
      const int k0 = kn * BK;
#pragma unroll
      for (int i = 0; i < ACH; ++i) {
        int ch = tid + i * 256;
        if (!ATRANS) { int row = ch / CPR, kc = ch % CPR; ra[i] = *(const U4*)(A + (size_t)(m0 + row) * lda + k0 + kc * 8); }
        else { int k = ch / (BM / 8), mc = ch % (BM / 8); ra[i] = *(const U4*)(A + (size_t)(k0 + k) * lda + m0 + mc * 8); }
      }
#pragma unroll
      for (int i = 0; i < BCH; ++i) {
        int ch = tid + i * 256; int row = ch / CPR, kc = ch % CPR;
        rb[i] = *(const U4*)(Bt + (size_t)(n0 + row) * ldb + k0 + kc * 8);
      }
    }
#pragma unroll
    for (int ks = 0; ks < BK / 32; ++ks) {
      bf16x8 af[MT], bfr[NTL];
#pragma unroll
      for (int mt = 0; mt < MT; ++mt) af[mt] = *(const bf16x8*)(sA + (wm * (BM / WM) + mt * 16 + c) * LDK + ks * 32 + g * 8);
#pragma unroll
      for (int nt = 0; nt < NTL; ++nt) bfr[nt] = *(const bf16x8*)(sB + (wn * (BN / WN) + nt * 16 + c) * LDK + ks * 32 + g * 8);
#pragma unroll
      for (int mt = 0; mt < MT; ++mt)
#pragma unroll
        for (int nt = 0; nt < NTL; ++nt)
          acc[mt][nt] = __builtin_amdgcn_mfma_f32_16x16x32_bf16(af[mt], bfr[nt], acc[mt][nt], 0, 0, 0);
    }
  }
}


template <int BM, int BN, int WM, int WN, bool SWAP = false>
__device__ __forceinline__ void gemm_glds(const u16* A, int lda, const u16* Bt, int ldb, int K, int m0, int n0,
                                          unsigned char* smem, f32x4 (&acc)[BM / WM / 16][BN / WN / 16]) {
  constexpr int MT = BM / WM / 16, NTL = BN / WN / 16;
  constexpr int TA = BM * 128, TB = BN * 128, STAGE = TA + TB;
  constexpr int GA = BM / 32, GB = BN / 32;
  const int tid = tidx(), lane = tid & 63, wave = __builtin_amdgcn_readfirstlane(tid >> 6);
  const int wm = wave / WN, wn = wave % WN;
  const int c = lane & 15, g = lane >> 4;
  const int rg = lane >> 3, kcs = ((lane & 7) ^ rg) * 8;
  const int nk = K / 64;
  const int krot = (int)((unsigned)(blockIdx.x >> 3) % (unsigned)nk);
  const u16* asrc = A + (size_t)(m0 + wave * 8 + rg) * lda + kcs;
  const u16* bsrc = Bt + (size_t)(n0 + wave * 8 + rg) * ldb + kcs;
#define GLDS_STAGE(buf, kt)                                                                                          \
  {                                                                                                                  \
    unsigned char* sa_ = smem + (buf) * STAGE + wave * 1024;                                                         \
    _Pragma("unroll") for (int i_ = 0; i_ < GA; ++i_)                                                                \
      __builtin_amdgcn_global_load_lds((const unsigned*)(asrc + (size_t)(i_ * 32) * lda + (kt) * 64),                \
                                       (unsigned*)(sa_ + i_ * 4096), 16, 0, 0);                                      \
    _Pragma("unroll") for (int i_ = 0; i_ < GB; ++i_)                                                                \
      __builtin_amdgcn_global_load_lds((const unsigned*)(bsrc + (size_t)(i_ * 32) * ldb + (kt) * 64),                \
                                       (unsigned*)(sa_ + TA + i_ * 4096), 16, 0, 0);                                 \
  }
  __syncthreads();
  GLDS_STAGE(0, krot)
  asm volatile("s_waitcnt vmcnt(0)" ::: "memory");
  __syncthreads();
#pragma unroll 4
  for (int kt = 0; kt < nk; ++kt) {
    const int cur = kt & 1;
    int kn = kt + 1 + krot; if (kn >= nk) kn -= nk;
    if (kt + 1 < nk) GLDS_STAGE(cur ^ 1, kn)
    const unsigned char* pa = smem + cur * STAGE;
    const unsigned char* pb = pa + TA;
#pragma unroll
    for (int ks = 0; ks < 2; ++ks) {
      bf16x8 af[MT], bfr[NTL];
      const int cho = (((ks * 4 + g) ^ (c & 7)) * 16);
#pragma unroll
      for (int mt = 0; mt < MT; ++mt) af[mt] = *(const bf16x8*)(pa + (wm * (BM / WM) + mt * 16 + c) * 128 + cho);
#pragma unroll
      for (int nt = 0; nt < NTL; ++nt) bfr[nt] = *(const bf16x8*)(pb + (wn * (BN / WN) + nt * 16 + c) * 128 + cho);
#pragma unroll
      for (int mt = 0; mt < MT; ++mt)
#pragma unroll
        for (int nt = 0; nt < NTL; ++nt)
          acc[mt][nt] = SWAP ? __builtin_amdgcn_mfma_f32_16x16x32_bf16(bfr[nt], af[mt], acc[mt][nt], 0, 0, 0)
                             : __builtin_amdgcn_mfma_f32_16x16x32_bf16(af[mt], bfr[nt], acc[mt][nt], 0, 0, 0);
    }
    asm volatile("s_waitcnt vmcnt(0)" ::: "memory");
    __syncthreads();
  }
#undef GLDS_STAGE
}

template <bool SWAP>
__device__ __forceinline__ void gemm_glds_at(const u16* At, int ldat, const u16* Bt, int ldb, int K, int m0, int n0,
                                             unsigned char* smem, f32x4 (&acc)[4][4]) {
  constexpr int IA = 1040, TA = 16 * IA, TB = 128 * 128, STAGE = TA + TB;
  const int tid = tidx(), lane = tid & 63, wave = __builtin_amdgcn_readfirstlane(tid >> 6);
  const int wm = wave >> 1, wn = wave & 1;
  const int c = lane & 15, g = lane >> 4;
  const int rg = lane >> 3, kcs = ((lane & 7) ^ rg) * 8;
  const int nk = K / 64;
  const int krot = (int)((unsigned)(blockIdx.x >> 3) % (unsigned)nk);
  const u16* asrc = At + (size_t)(wave * 4 + (lane >> 4)) * ldat + m0 + (lane & 15) * 8;
  const u16* bsrc = Bt + (size_t)(n0 + wave * 8 + rg) * ldb + kcs;
#define GLDS_STAGE_AT(buf, kt)                                                                                       \
  {                                                                                                                  \
    unsigned char* sa_ = smem + (buf) * STAGE;                                                                       \
    _Pragma("unroll") for (int i_ = 0; i_ < 4; ++i_)                                                                 \
      __builtin_amdgcn_global_load_lds((const unsigned*)(asrc + (size_t)((kt) * 64 + i_ * 16) * ldat),               \
                                       (unsigned*)(sa_ + (wave + i_ * 4) * IA), 16, 0, 0);                           \
    _Pragma("unroll") for (int i_ = 0; i_ < 4; ++i_)                                                                 \
      __builtin_amdgcn_global_load_lds((const unsigned*)(bsrc + (size_t)(i_ * 32) * ldb + (kt) * 64),                \
                                       (unsigned*)(sa_ + TA + wave * 1024 + i_ * 4096), 16, 0, 0);                   \
  }
  __syncthreads();
  GLDS_STAGE_AT(0, krot)
  asm volatile("s_waitcnt vmcnt(0)" ::: "memory");
  __syncthreads();
#pragma unroll 2
  for (int kt = 0; kt < nk; ++kt) {
    const int cur = kt & 1;
    int kn = kt + 1 + krot; if (kn >= nk) kn -= nk;
    if (kt + 1 < nk) GLDS_STAGE_AT(cur ^ 1, kn)
    const unsigned char* pa = smem + cur * STAGE;
    const unsigned char* pb = pa + TA;
#pragma unroll
    for (int ks = 0; ks < 2; ++ks) {
      bf16x8 af[4], bfr[4];
      const int cho = (((ks * 4 + g) ^ (c & 7)) * 16);
#pragma unroll
      for (int mt = 0; mt < 4; ++mt) {
        const unsigned char* q = pa + (ks * 8 + 2 * g) * IA + (wm * 64 + mt * 16 + c) * 2;
        const unsigned e0 = *(const u16*)(q), e1 = *(const u16*)(q + 256), e2 = *(const u16*)(q + 512), e3 = *(const u16*)(q + 768);
        const unsigned e4 = *(const u16*)(q + IA), e5 = *(const u16*)(q + IA + 256), e6 = *(const u16*)(q + IA + 512), e7 = *(const u16*)(q + IA + 768);
        U4 w = {e0 | (e1 << 16), e2 | (e3 << 16), e4 | (e5 << 16), e6 | (e7 << 16)};
        af[mt] = __builtin_bit_cast(bf16x8, w);
      }
#pragma unroll
      for (int nt = 0; nt < 4; ++nt) bfr[nt] = *(const bf16x8*)(pb + (wn * 64 + nt * 16 + c) * 128 + cho);
#pragma unroll
      for (int mt = 0; mt < 4; ++mt)
#pragma unroll
        for (int nt = 0; nt < 4; ++nt)
          acc[mt][nt] = SWAP ? __builtin_amdgcn_mfma_f32_16x16x32_bf16(bfr[nt], af[mt], acc[mt][nt], 0, 0, 0)
                             : __builtin_amdgcn_mfma_f32_16x16x32_bf16(af[mt], bfr[nt], acc[mt][nt], 0, 0, 0);
    }
    asm volatile("s_waitcnt vmcnt(0)" ::: "memory");
    __syncthreads();
  }
#undef GLDS_STAGE_AT
}

__device__ __forceinline__ void ph_x_prep(const Params& p, int bid, int nb) {
  const int lane = tidx() & 63, wave = __builtin_amdgcn_readfirstlane(tidx() >> 6);
  for (int r = (bid * 4 + wave) * 2; r < T_TOK; r += nb * 8) {
    const F4* xr = (const F4*)(p.x + (size_t)r * 1024);
    F4 v[8]; float ss0 = 0.f, ss1 = 0.f;
#pragma unroll
    for (int i = 0; i < 8; ++i) v[i] = xr[lane + 64 * i];
#pragma unroll
    for (int i = 0; i < 4; ++i) {
      ss0 += v[i].x * v[i].x + v[i].y * v[i].y + v[i].z * v[i].z + v[i].w * v[i].w;
      ss1 += v[4 + i].x * v[4 + i].x + v[4 + i].y * v[4 + i].y + v[4 + i].z * v[4 + i].z + v[4 + i].w * v[4 + i].w;
    }
    ss0 = wave_sum(ss0); ss1 = wave_sum(ss1);
    if (lane == 0) { p.rstd1[r] = rsqrtf(ss0 * (1.f / 1024.f) + EPS); p.rstd1[r + 1] = rsqrtf(ss1 * (1.f / 1024.f) + EPS); }
#pragma unroll
    for (int i = 0; i < 8; ++i) {
      const F4 g4 = ((const F4*)p.attn_norm)[lane + 64 * (i & 3)];
      U2 o; o.x = pack2(v[i].x * g4.x, v[i].y * g4.y); o.y = pack2(v[i].z * g4.z, v[i].w * g4.w);
      ((U2*)(p.xb + (size_t)r * 1024))[lane + 64 * i] = o;
    }
  }
}

__device__ __forceinline__ void ph_transpose(const float* W, int K, int N, int Npad, u16* Wt, const float* ks, float* tile, int bid, int nb) {
  const int ntk = K / 64, ntn = Npad / 64;
  for (int it = bid; it < ntk * ntn; it += nb) {
    const int kt = it % ntk, nt = it / ntk; const int k0 = kt * 64, n0 = nt * 64;
    __syncthreads();
    for (int e = tidx(); e < 4096; e += 256) {
      int i = e >> 6, j = e & 63; int n = n0 + j;
      float v = (n < N) ? W[(size_t)(k0 + i) * N + n] : 0.f;
      if (ks) v *= ks[k0 + i];
      tile[i * 65 + j] = v;
    }
    __syncthreads();
    for (int e = tidx(); e < 4096; e += 256) {
      int j = e >> 6, i = e & 63;
      Wt[(size_t)(n0 + j) * K + k0 + i] = f2bf(tile[i * 65 + j]);
    }
  }
}

__device__ __forceinline__ void ph_convert(const float* src, u16* dst, size_t n4, int bid, int nb) {
  for (size_t i = (size_t)bid * 256 + tidx(); i < n4; i += (size_t)nb * 256) {
    F4 v = ((const F4*)src)[i];
    U2 o; o.x = pack2(v.x, v.y); o.y = pack2(v.z, v.w);
    ((U2*)dst)[i] = o;
  }
}

__device__ __forceinline__ void ph_filter_trunk(const Params& p, float* sm, int bid, int nb) {
  const int sub = __builtin_amdgcn_readfirstlane(tidx() >> 6), o = tidx() & 63;
  float* bufA = sm + sub * 128; float* bufB = bufA + 64;
  const float fr = p.ffreq[o];
  for (int it = bid; it < 512; it += nb) {
    const int t = it * 4 + sub;
    __syncthreads();
    if (o < 33) {
      float zv;
      if (o == 0) zv = (float)t / 2047.f;
      else {
        int i = (o - 1) & 15;
        float f = 1e-4f + (float)i * ((15.f - 1e-4f) / 15.f);
        float w = 6.283185307179586f * (float)t / 2048.f;
        float a = f * w;
        zv = (o <= 16) ? cosf(a) : -sinf(a);
      }
      bufA[o] = zv;
    }
    __syncthreads();
    float s = p.fb1[o];
#pragma unroll 11
    for (int k = 0; k < 33; ++k) s += bufA[k] * p.fw1[k * 64 + o];
    bufB[o] = sinf(fr * s);
    __syncthreads();
    s = p.fb2[o];
#pragma unroll 16
    for (int k = 0; k < 64; ++k) s += bufB[k] * p.fw2[k * 64 + o];
    bufA[o] = sinf(fr * s);
    __syncthreads();
    s = p.fb3[o];
#pragma unroll 16
    for (int k = 0; k < 64; ++k) s += bufA[k] * p.fw3[k * 64 + o];
    p.h3[t * 64 + o] = sinf(fr * s);
  }
}

__device__ __forceinline__ void phase0(const Params& p, unsigned char* smem, int bid, int nb) {
  float* tile = (float*)smem;
  ph_x_prep(p, bid, nb);
  ph_transpose(p.w_in, 1024, 4000, 4096, p.w_inT, nullptr, tile, bid, nb);
  ph_transpose(p.w_uq, 256, 768, 768, p.w_uqT, p.q_a_norm, tile, (bid + 64) % nb, nb);
  ph_transpose(p.w_ukv, 128, 1024, 1024, p.w_ukvT, p.kv_a_norm, tile, (bid + 128) % nb, nb);
  ph_transpose(p.w_o_attn, 512, 1024, 1024, p.w_oaT, nullptr, tile, (bid + 160) % nb, nb);
  ph_transpose(p.w_o_hyena, 512, 1024, 1024, p.w_ohT, nullptr, tile, (bid + 32) % nb, nb);
  ph_transpose(p.w_out, 1024, 1024, 1024, p.w_outT, nullptr, tile, (bid + 96) % nb, nb);
  ph_convert(p.peer_wq, p.wqb, (size_t)1024 * 2048 / 4, bid, nb);
  ph_convert(p.keys1, p.keysb, (size_t)8 * 128 * 128 / 4, bid, nb);
  ph_convert(p.keys2, p.keysb + 8 * 128 * 128, (size_t)8 * 128 * 128 / 4, bid, nb);
  __syncthreads();
  ph_filter_trunk(p, tile, nb - 1 - bid, nb);
}

__device__ __forceinline__ void filter_item(const Params& p, unsigned char* smem, int j) {
  const int tid = tidx();
  const int cp = (j & 3) * 256 + tid, t0 = (j >> 2) * 8;
  const int c = cp & 511;
  float* hl = (float*)smem;
  __syncthreads();
  {
    const float2 v = *(const float2*)(p.h3 + (size_t)t0 * 64 + tid * 2);
    hl[tid * 2] = v.x; hl[tid * 2 + 1] = v.y;
  }
  float w[64];
#pragma unroll
  for (int k = 0; k < 64; ++k) w[k] = p.fw4[k * 1024 + cp];
  const float dmin = -3.0701134573253943f, dmax = -15.350567286626972f;
  const float delta = fabsf(dmin + (float)c * ((dmax - dmin) / 511.f));
  const float b4 = p.fb4[cp];
  __syncthreads();
  float o[8];
#pragma unroll
  for (int i = 0; i < 8; ++i) {
    const int t = t0 + i;
    float sacc = 0.f;
#pragma unroll
    for (int k4 = 0; k4 < 16; ++k4) { const F4 hv = *(const F4*)(hl + i * 64 + k4 * 4); sacc += hv.x * w[k4 * 4] + hv.y * w[k4 * 4 + 1] + hv.z * w[k4 * 4 + 2] + hv.w * w[k4 * 4 + 3]; }
    float v = (sacc + b4) * expf(-((float)t / 2047.f) * delta);
    if (t == 0 && cp < 512) v += p.hbias[c];
    o[i] = v;
  }
  U4 ov; ov.x = pack2(o[0], o[1]); ov.y = pack2(o[2], o[3]); ov.z = pack2(o[4], o[5]); ov.w = pack2(o[6], o[7]);
  *(U4*)(p.filt + (size_t)cp * 2048 + t0) = ov;
}

__device__ __forceinline__ void qkv_items(const Params& p, unsigned char* smem, int bid, int nb);
template <int MODE>
__device__ __forceinline__ void phase1(const Params& p, unsigned char* smem, int bid, int nb) {
  const int lane = tidx() & 63, wave = __builtin_amdgcn_readfirstlane(tidx() >> 6);
  const int wm = wave >> 1, wn = wave & 1, c = lane & 15, g = lane >> 4;
  const int NTILES = (MODE == 0) ? 512 : 3584;
  const int NITEMS = (MODE == 0) ? NTILES : NTILES + 128 + 1024;
  if (MODE == 1 && bid >= (nb >> 1)) qkv_items(p, smem, bid, nb);
  for (int it = bid; it < NITEMS; it += nb) {
    if (it >= NTILES + 128) { filter_item(p, smem, it - NTILES - 128); continue; }
    f32x4 acc[4][4];
#pragma unroll
    for (int i = 0; i < 4; ++i)
#pragma unroll
      for (int j = 0; j < 4; ++j) acc[i][j] = f32x4{0.f, 0.f, 0.f, 0.f};
    if (it < NTILES) {
      const int rr_ = it >> 9, xx_ = it & 7, li_ = (it & 511) >> 3;
      const int ntile = ((MODE == 0) ? 0 : 4 + 4 * rr_) + (li_ >> 4);
      const int m0 = (16 * xx_ + (li_ & 15)) * 128, n0 = ntile * 128;
      if (ntile < 3 || ntile >= 16) {
        gemm_glds<128, 128, 2, 2, true>(p.xb, 1024, p.w_inT, 1024, 1024, m0, n0, smem, acc);
#pragma unroll
        for (int mt = 0; mt < 4; ++mt) {
          const int t = m0 + wm * 64 + mt * 16 + c;
          const float rs = p.rstd1[t];
#pragma unroll
          for (int nt = 0; nt < 4; ++nt) {
            const int n = n0 + wn * 64 + nt * 16 + g * 4;
            float v[4];
#pragma unroll
            for (int r = 0; r < 4; ++r) v[r] = acc[mt][nt][r] * rs;
            if (ntile < 2) {
              U2 o; o.x = pack2(v[0], v[1]); o.y = pack2(v[2], v[3]);
              *(U2*)(p.cq + (size_t)t * 256 + n) = o;
            } else if (ntile == 2) {
              U2 o; o.x = pack2(v[0], v[1]); o.y = pack2(v[2], v[3]);
              *(U2*)(p.ckv + (size_t)t * 160 + (n - 256)) = o;
            } else if (n < 4000) {
              const F4 bg = *(const F4*)(p.b_gate + (n - 1952));
              const float s0 = 1.f / (1.f + __expf(-(v[0] + bg.x))), s1 = 1.f / (1.f + __expf(-(v[1] + bg.y)));
              const float s2 = 1.f / (1.f + __expf(-(v[2] + bg.z))), s3 = 1.f / (1.f + __expf(-(v[3] + bg.w)));
              U2 o; o.x = pack2(s0, s1); o.y = pack2(s2, s3);
              *(U2*)(p.gates + (size_t)t * 2048 + (n - 1952)) = o;
            }
          }
        }
        continue;
      }
      gemm_glds<128, 128, 2, 2>(p.xb, 1024, p.w_inT, 1024, 1024, m0, n0, smem, acc);
#pragma unroll
      for (int mt = 0; mt < 4; ++mt) {
        const int t0 = m0 + wm * 64 + mt * 16 + g * 4;
        float rs[4];
#pragma unroll
        for (int r = 0; r < 4; ++r) rs[r] = p.rstd1[t0 + r];
#pragma unroll
        for (int nt = 0; nt < 4; ++nt) {
          const int nb0 = n0 + wn * 64 + nt * 16;
          const int n = nb0 + c;
          float v[4];
#pragma unroll
          for (int r = 0; r < 4; ++r) v[r] = acc[mt][nt][r] * rs[r];
          if (nb0 < 256) {
#pragma unroll
            for (int r = 0; r < 4; ++r) p.cq[(size_t)(t0 + r) * 256 + n] = f2bf(v[r]);
          } else if (nb0 < 416) {
#pragma unroll
            for (int r = 0; r < 4; ++r) p.ckv[(size_t)(t0 + r) * 160 + (n - 256)] = f2bf(v[r]);
          } else if (nb0 < 1952) {
            U2 o; o.x = pack2(v[0], v[1]); o.y = pack2(v[2], v[3]);
            *(U2*)(p.uT + (size_t)(n - 416) * T_TOK + t0) = o;
          } else if (nb0 < 4000) {
            const float bg = p.b_gate[n - 1952];
#pragma unroll
            for (int r = 0; r < 4; ++r) {
              float s = 1.f / (1.f + __expf(-(v[r] + bg)));
              p.gates[(size_t)(t0 + r) * 2048 + (n - 1952)] = f2bf(s);
            }
          }
        }
      }
    } else {
      const int j = it - NTILES; const int hs = j >> 3, kt = j & 7; const int h = hs >> 1, side = hs & 1;
      const u16* A = p.keysb + (size_t)((side * 8 + h) * 128) * 128;
      const u16* Bt = p.wqb + h * 256 + side * 128;
      gemm_glds<128, 128, 2, 2>(A, 128, Bt, 2048, 128, 0, kt * 128, smem, acc);
#pragma unroll
      for (int mt = 0; mt < 4; ++mt)
#pragma unroll
        for (int nt = 0; nt < 4; ++nt)
#pragma unroll
          for (int r = 0; r < 4; ++r) {
            int key = wm * 64 + mt * 16 + g * 4 + r; int k = kt * 128 + wn * 64 + nt * 16 + c;
            p.wcT[(size_t)(h * 256 + side * 128 + key) * 1024 + k] = f2bf(acc[mt][nt][r]);
          }
    }
  }
  if (MODE == 1 && bid < (nb >> 1)) qkv_items(p, smem, bid, nb);
}

__device__ __forceinline__ void hyena_channel(const Params& p, unsigned char* smem, int c) {
  u16* Zl = (u16*)smem;
  u16* R0 = (u16*)(smem + 36864);
  u16* R1 = (u16*)(smem + 36864 + 8192);
  const int tid = tidx(), lane = tid & 63, wave = __builtin_amdgcn_readfirstlane(tid >> 6);
  __syncthreads();
  if (tid == 0) { R0[0] = 0; R1[4095] = 0; }
  {
    const float w1a = p.conv_w[512 + c], w1b = p.conv_w[1536 + 512 + c], w1c = p.conv_w[3072 + 512 + c], b1 = p.conv_b[512 + c];
    const float wva = p.conv_w[1024 + c], wvb = p.conv_w[1536 + 1024 + c], wvc = p.conv_w[3072 + 1024 + c], bv = p.conv_b[1024 + c];
    const int s0 = tid * 8;
#pragma unroll 4
    for (int b = 0; b < 8; ++b) {
      const u16* u1 = p.uT + (size_t)(512 + c) * T_TOK + b * SEQ;
      const u16* uv = p.uT + (size_t)(1024 + c) * T_TOK + b * SEQ;
      U4 a = *(const U4*)(u1 + s0), d = *(const U4*)(uv + s0);
      float x[10], y[10];
      x[0] = (s0 > 0) ? bf2f(u1[s0 - 1]) : 0.f; y[0] = (s0 > 0) ? bf2f(uv[s0 - 1]) : 0.f;
      x[9] = (s0 + 8 < SEQ) ? bf2f(u1[s0 + 8]) : 0.f; y[9] = (s0 + 8 < SEQ) ? bf2f(uv[s0 + 8]) : 0.f;
      x[1] = bflo(a.x); x[2] = bfhi(a.x); x[3] = bflo(a.y); x[4] = bfhi(a.y); x[5] = bflo(a.z); x[6] = bfhi(a.z); x[7] = bflo(a.w); x[8] = bfhi(a.w);
      y[1] = bflo(d.x); y[2] = bfhi(d.x); y[3] = bflo(d.y); y[4] = bfhi(d.y); y[5] = bflo(d.z); y[6] = bfhi(d.z); y[7] = bflo(d.w); y[8] = bfhi(d.w);
      float z[8];
#pragma unroll
      for (int i = 0; i < 8; ++i) {
        float x1 = w1a * x[i] + w1b * x[i + 1] + w1c * x[i + 2] + b1;
        float vv = wva * y[i] + wvb * y[i + 1] + wvc * y[i + 2] + bv;
        z[i] = x1 * vv;
      }
      U4 o; o.x = pack2(z[0], z[1]); o.y = pack2(z[2], z[3]); o.z = pack2(z[4], z[5]); o.w = pack2(z[6], z[7]);
      *(U4*)(Zl + b * ZS + 96 + s0) = o;
      if (tid < 200) { int idx = (tid < 96) ? tid : (SEQ + tid); Zl[b * ZS + idx] = 0; }
    }
  }
  __syncthreads();
  {
    const int t0 = tid * 8;
    const U4 ff = *(const U4*)(p.filt + (size_t)c * 2048 + t0);
    const U4 fb = *(const U4*)(p.filt + (size_t)(512 + c) * 2048 + t0);
    u16 f[8], bw[8];
    f[0] = (u16)(ff.x & 0xffff); f[1] = (u16)(ff.x >> 16); f[2] = (u16)(ff.y & 0xffff); f[3] = (u16)(ff.y >> 16);
    f[4] = (u16)(ff.z & 0xffff); f[5] = (u16)(ff.z >> 16); f[6] = (u16)(ff.w & 0xffff); f[7] = (u16)(ff.w >> 16);
    bw[0] = (u16)(fb.x & 0xffff); bw[1] = (u16)(fb.x >> 16); bw[2] = (u16)(fb.y & 0xffff); bw[3] = (u16)(fb.y >> 16);
    bw[4] = (u16)(fb.z & 0xffff); bw[5] = (u16)(fb.z >> 16); bw[6] = (u16)(fb.w & 0xffff); bw[7] = (u16)(fb.w >> 16);
#pragma unroll
    for (int i = 0; i < 8; ++i) {
      const int t = t0 + i;
      R0[2048 - t] = f[i]; R1[2047 - t] = f[i];
      if (t >= 1) { R0[2048 + t] = bw[i]; R1[2047 + t] = bw[i]; }
    }
  }
  __syncthreads();
  f32x16 acc[4];
#pragma unroll
  for (int i = 0; i < 4; ++i)
#pragma unroll
    for (int j = 0; j < 16; ++j) acc[i][j] = 0.f;
  const int r = lane & 31, hh = lane >> 5;
  const int bb = r >> 2, ii = r & 3;
  {
    const unsigned* Rw = (const unsigned*)((r & 1) ? R1 : R0);
    const int abase = (2048 - r + 8 * hh - (r & 1)) >> 1;
    const u16* zb = Zl + bb * ZS + 96 + 32 * ii + 8 * hh;
    const int dlo = 16 * wave - 63, dhi = 16 * wave + 15;
#pragma unroll 1
    for (int d = dlo; d <= dhi; ++d) {
      bf16x8 a0, a1;
      {
        const unsigned* q = Rw + abase - 16 * d;
        unsigned w0 = q[0], w1 = q[1], w2 = q[2], w3 = q[3], w4 = q[8], w5 = q[9], w6 = q[10], w7 = q[11];
        typedef __attribute__((ext_vector_type(4))) unsigned u32x4;
        u32x4 t0 = {w0, w1, w2, w3}, t1 = {w4, w5, w6, w7};
        a0 = __builtin_bit_cast(bf16x8, t0); a1 = __builtin_bit_cast(bf16x8, t1);
      }
#pragma unroll
      for (int nt = 0; nt < 4; ++nt) {
        const int i0 = 16 * wave + 4 * nt;
        if (d >= i0 - 63 && d <= i0 + 3) {
          const u16* zp = zb + 32 * (i0 - d);
          bf16x8 b0 = *(const bf16x8*)(zp);
          bf16x8 b1 = *(const bf16x8*)(zp + 16);
          acc[nt] = __builtin_amdgcn_mfma_f32_32x32x16_bf16(a0, b0, acc[nt], 0, 0, 0);
          acc[nt] = __builtin_amdgcn_mfma_f32_32x32x16_bf16(a1, b1, acc[nt], 0, 0, 0);
        }
      }
    }
  }
  __syncthreads();
  {
    const float w0a = p.conv_w[c], w0b = p.conv_w[1536 + c], w0c = p.conv_w[3072 + c], b0 = p.conv_b[c];
    const int s0 = tid * 8;
#pragma unroll 8
    for (int b = 0; b < 8; ++b) {
      const u16* u0 = p.uT + (size_t)c * T_TOK + b * SEQ;
      U4 a = *(const U4*)(u0 + s0);
      float x[10];
      x[0] = (s0 > 0) ? bf2f(u0[s0 - 1]) : 0.f;
      x[9] = (s0 + 8 < SEQ) ? bf2f(u0[s0 + 8]) : 0.f;
      x[1] = bflo(a.x); x[2] = bfhi(a.x); x[3] = bflo(a.y); x[4] = bfhi(a.y); x[5] = bflo(a.z); x[6] = bfhi(a.z); x[7] = bflo(a.w); x[8] = bfhi(a.w);
      float z[8];
#pragma unroll
      for (int i = 0; i < 8; ++i) z[i] = w0a * x[i] + w0b * x[i + 1] + w0c * x[i + 2] + b0;
      U4 o; o.x = pack2(z[0], z[1]); o.y = pack2(z[2], z[3]); o.z = pack2(z[4], z[5]); o.w = pack2(z[6], z[7]);
      *(U4*)(Zl + b * ZS + 96 + s0) = o;
    }
  }
  __syncthreads();
#pragma unroll
  for (int nt = 0; nt < 4; ++nt) {
    const int i0 = 16 * wave + 4 * nt;
#pragma unroll
    for (int rg = 0; rg < 4; ++rg) {
      const int ts = 32 * (i0 + ii) + 8 * rg + 4 * hh;
      U2 xv = *(const U2*)(Zl + bb * ZS + 96 + ts);
      U2 o;
      o.x = pack2(acc[nt][rg * 4 + 0] * bflo(xv.x), acc[nt][rg * 4 + 1] * bfhi(xv.x));
      o.y = pack2(acc[nt][rg * 4 + 2] * bflo(xv.y), acc[nt][rg * 4 + 3] * bfhi(xv.y));
      *(U2*)(p.yhT + (size_t)c * T_TOK + bb * SEQ + ts) = o;
    }
  }
}

__device__ __forceinline__ void q_tile(const Params& p, unsigned char* smem, int mtile, int h) {
  u16* sA = (u16*)smem; u16* sB = (u16*)(smem + OFF_SB); float* rsq = (float*)(smem + OFF_RS);
  const int tid = tidx(), lane = tid & 63, wave = __builtin_amdgcn_readfirstlane(tid >> 6), c = lane & 15, g = lane >> 4;
  const int m0 = mtile * 128;
  __syncthreads();
  {
    const int row = tid >> 1, half = tid & 1;
    const U4* src = (const U4*)(p.cq + (size_t)(m0 + row) * 256 + half * 128);
    float ss = 0.f;
#pragma unroll
    for (int i = 0; i < 16; ++i) {
      U4 v = src[i];
      float a;
      a = bflo(v.x); ss += a * a; a = bfhi(v.x); ss += a * a; a = bflo(v.y); ss += a * a; a = bfhi(v.y); ss += a * a;
      a = bflo(v.z); ss += a * a; a = bfhi(v.z); ss += a * a; a = bflo(v.w); ss += a * a; a = bfhi(v.w); ss += a * a;
    }
    ss += __shfl_xor(ss, 1);
    if (half == 0) rsq[row] = rsqrtf(ss * (1.f / 256.f) + EPS);
  }
  f32x4 acc[2][6];
#pragma unroll
  for (int i = 0; i < 2; ++i)
#pragma unroll
    for (int j = 0; j < 6; ++j) acc[i][j] = f32x4{0.f, 0.f, 0.f, 0.f};
  gemm_main<128, 96, 4, 1, false, 128>(p.cq, 256, p.w_uqT, 256, 256, m0, h * 96, sA, sB, acc);
  const float QSCALE = 0.10206207261596575f * 1.4426950408889634f;
  const float invf = powf(10000.f, -(float)c / 16.f);
  float gn[6];
#pragma unroll
  for (int nt = 0; nt < 6; ++nt) gn[nt] = p.q_norm[nt * 16 + c];
#pragma unroll
  for (int mt = 0; mt < 2; ++mt)
#pragma unroll
    for (int r = 0; r < 4; ++r) {
      const int rl = wave * 32 + mt * 16 + g * 4 + r;
      const int t = m0 + rl; const int b = t >> 11, s = t & 2047;
      const float rs = rsq[rl];
      float q[6]; float ss = 0.f;
#pragma unroll
      for (int nt = 0; nt < 6; ++nt) { q[nt] = acc[mt][nt][r] * rs; ss += q[nt] * q[nt]; }
      ss = sum16(ss);
      const float rn = rsqrtf(ss * (1.f / 96.f) + EPS);
      u16* dst = p.Q + ((size_t)(b * 8 + h) * SEQ + s) * 96;
#pragma unroll
      for (int nt = 0; nt < 4; ++nt) dst[nt * 16 + c] = f2bf(q[nt] * rn * gn[nt] * QSCALE);
      const float x1 = q[4] * rn * gn[4], x2 = q[5] * rn * gn[5];
      float sn, cs; sincosf((float)s * invf, &sn, &cs);
      dst[64 + c] = f2bf((x1 * cs - x2 * sn) * QSCALE);
      dst[80 + c] = f2bf((x2 * cs + x1 * sn) * QSCALE);
    }
}

__device__ __forceinline__ void kv_tile(const Params& p, unsigned char* smem, int mtile, int h) {
  u16* sA = (u16*)smem; u16* sB = (u16*)(smem + OFF_SB); float* rsq = (float*)(smem + OFF_RS);
  const int tid = tidx(), lane = tid & 63, wave = __builtin_amdgcn_readfirstlane(tid >> 6), c = lane & 15, g = lane >> 4;
  const int wm = wave >> 1, wn = wave & 1;
  const int m0 = mtile * 128;
  __syncthreads();
  {
    const int row = tid >> 1, half = tid & 1;
    const U4* src = (const U4*)(p.ckv + (size_t)(m0 + row) * 160 + half * 64);
    float ss = 0.f;
#pragma unroll
    for (int i = 0; i < 8; ++i) {
      U4 v = src[i];
      float a;
      a = bflo(v.x); ss += a * a; a = bfhi(v.x); ss += a * a; a = bflo(v.y); ss += a * a; a = bfhi(v.y); ss += a * a;
      a = bflo(v.z); ss += a * a; a = bfhi(v.z); ss += a * a; a = bflo(v.w); ss += a * a; a = bfhi(v.w); ss += a * a;
    }
    ss += __shfl_xor(ss, 1);
    if (half == 0) rsq[row] = rsqrtf(ss * (1.f / 128.f) + EPS);
  }
  f32x4 acc[4][4];
#pragma unroll
  for (int i = 0; i < 4; ++i)
#pragma unroll
    for (int j = 0; j < 4; ++j) acc[i][j] = f32x4{0.f, 0.f, 0.f, 0.f};
  gemm_main<128, 128, 2, 2, false, 128>(p.ckv, 160, p.w_ukvT, 128, 128, m0, h * 128, sA, sB, acc);
  if (wn == 0) {
    const float invf = powf(10000.f, -(float)c / 16.f);
    float gn[6];
#pragma unroll
    for (int nt = 0; nt < 6; ++nt) gn[nt] = p.k_norm[nt * 16 + c];
#pragma unroll
    for (int mt = 0; mt < 4; ++mt)
#pragma unroll
      for (int r = 0; r < 4; ++r) {
        const int rl = wm * 64 + mt * 16 + g * 4 + r;
        const int t = m0 + rl; const int b = t >> 11, s = t & 2047;
        const float rs = rsq[rl];
        float kn[4]; float ss = 0.f;
#pragma unroll
        for (int nt = 0; nt < 4; ++nt) { kn[nt] = acc[mt][nt][r] * rs; ss += kn[nt] * kn[nt]; }
        const float pe1 = bf2f(p.ckv[(size_t)t * 160 + 128 + c]), pe2 = bf2f(p.ckv[(size_t)t * 160 + 144 + c]);
        ss += pe1 * pe1 + pe2 * pe2;
        ss = sum16(ss);
        const float rn = rsqrtf(ss * (1.f / 96.f) + EPS);
        u16* dst = p.K + ((size_t)(b * 8 + h) * SEQ + s) * 96;
#pragma unroll
        for (int nt = 0; nt < 4; ++nt) dst[nt * 16 + c] = f2bf(kn[nt] * rn * gn[nt]);
        const float x1 = pe1 * rn * gn[4], x2 = pe2 * rn * gn[5];
        float sn, cs; sincosf((float)s * invf, &sn, &cs);
        dst[64 + c] = f2bf(x1 * cs - x2 * sn);
        dst[80 + c] = f2bf(x2 * cs + x1 * sn);
      }
  } else {
#pragma unroll
    for (int mt = 0; mt < 4; ++mt) {
      const int rl = wm * 64 + mt * 16 + g * 4;
      const int t = m0 + rl; const int b = t >> 11, s = t & 2047;
      float rs[4];
#pragma unroll
      for (int r = 0; r < 4; ++r) rs[r] = rsq[rl + r];
#pragma unroll
      for (int nt = 0; nt < 4; ++nt) {
        const int dcol = nt * 16 + c;
        U2 o; o.x = pack2(acc[mt][nt][0] * rs[0], acc[mt][nt][1] * rs[1]); o.y = pack2(acc[mt][nt][2] * rs[2], acc[mt][nt][3] * rs[3]);
        *(U2*)(p.Vt + ((size_t)(b * 8 + h) * 64 + dcol) * SEQ + s) = o;
      }
    }
  }
}

__device__ __forceinline__ void qkv_items(const Params& p, unsigned char* smem, int bid, int nb) {
  for (int it = bid; it < 1024 + 1024; it += nb) {
    if (it < 1024) { q_tile(p, smem, it >> 3, it & 7); }
    else { int j = it - 1024; kv_tile(p, smem, j >> 3, j & 7); }
  }
}

typedef float f32x2 __attribute__((ext_vector_type(2)));
__device__ __forceinline__ void ph_expert_fp8(const float* src, unsigned char* dst, float* inv_scale, int bid, int nb) {
  const int tid = tidx(), lane = tid & 63, wave = __builtin_amdgcn_readfirstlane(tid >> 6);
  for (int r = bid * 4 + wave; r < 16384; r += nb * 4) {
    const F4* sr = (const F4*)(src + (size_t)r * 1024 + lane * 16);
    F4 v[4]; float mx = 0.f;
#pragma unroll
    for (int i = 0; i < 4; ++i) { v[i] = sr[i]; mx = fmaxf(mx, fmaxf(fmaxf(fabsf(v[i].x), fabsf(v[i].y)), fmaxf(fabsf(v[i].z), fabsf(v[i].w)))); }
#pragma unroll
    for (int o = 32; o > 0; o >>= 1) mx = fmaxf(mx, __shfl_xor(mx, o));
    const float sc = (mx > 0.f) ? 224.f / mx : 1.f;
    if (lane == 0) inv_scale[r] = (mx > 0.f) ? mx * (1.f / 224.f) : 1.f;
    U4 o;
#pragma unroll
    for (int i = 0; i < 4; ++i) {
      int w = __builtin_amdgcn_cvt_pk_fp8_f32(v[i].x * sc, v[i].y * sc, 0, false);
      w = __builtin_amdgcn_cvt_pk_fp8_f32(v[i].z * sc, v[i].w * sc, w, true);
      o[i] = (unsigned)w;
    }
    *(U4*)(dst + (size_t)r * 1024 + lane * 16) = o;
  }
}

__device__ __forceinline__ void phase3(const Params& p, unsigned char* smem, int bid, int nb) {
  constexpr int KS = 104, VS = 72;
  u16* sK = (u16*)smem;
  u16* sV = (u16*)(smem + 13312);
  const int tid = tidx(), lane = tid & 63, wave = __builtin_amdgcn_readfirstlane(tid >> 6), c = lane & 15, g = lane >> 4;
  if (bid >= (nb >> 1)) { for (int ch = bid; ch < 512; ch += nb) hyena_channel(p, smem, ch); }
  for (int it = bid; it < 1024; it += nb) {
    const int qb = it & 15, bh = it >> 4;
    const u16* Qp = p.Q + ((size_t)bh * SEQ + qb * 128 + wave * 32) * 96;
    const u16* Kp = p.K + (size_t)bh * SEQ * 96;
    const u16* Vp = p.Vt + (size_t)bh * 64 * SEQ;
    bf16x8 qf[2][3];
#pragma unroll
    for (int qt = 0; qt < 2; ++qt)
#pragma unroll
      for (int ks = 0; ks < 3; ++ks) qf[qt][ks] = *(const bf16x8*)(Qp + (size_t)(qt * 16 + c) * 96 + ks * 32 + g * 8);
    f32x4 O[4][2];
#pragma unroll
    for (int i = 0; i < 4; ++i)
#pragma unroll
      for (int j = 0; j < 2; ++j) O[i][j] = f32x4{0.f, 0.f, 0.f, 0.f};
    float mrun[2] = {-1e30f, -1e30f}, lrun[2] = {0.f, 0.f};
    U4 rk[3], rv[2];
    const int krot = (blockIdx.x >> 3) & 31;
#pragma unroll
    for (int i = 0; i < 3; ++i) { int ch = tid + i * 256; int row = ch / 12, kc = ch % 12; rk[i] = *(const U4*)(Kp + (size_t)(krot * 64 + row) * 96 + kc * 8); }
#pragma unroll
    for (int i = 0; i < 2; ++i) { int ch = tid + i * 256; int row = ch >> 3, kc = ch & 7; rv[i] = *(const U4*)(Vp + (size_t)row * SEQ + krot * 64 + kc * 8); }
    for (int kt = 0; kt < 32; ++kt) {
      __syncthreads();
#pragma unroll
      for (int i = 0; i < 3; ++i) { int ch = tid + i * 256; int row = ch / 12, kc = ch % 12; *(U4*)(sK + row * KS + kc * 8) = rk[i]; }
#pragma unroll
      for (int i = 0; i < 2; ++i) { int ch = tid + i * 256; int row = ch >> 3, kc = ch & 7; *(U4*)(sV + row * VS + kc * 8) = rv[i]; }
      __syncthreads();
      if (kt + 1 < 32) {
        const int k0 = ((kt + 1 + krot) & 31) * 64;
#pragma unroll
        for (int i = 0; i < 3; ++i) { int ch = tid + i * 256; int row = ch / 12, kc = ch % 12; rk[i] = *(const U4*)(Kp + (size_t)(k0 + row) * 96 + kc * 8); }
#pragma unroll
        for (int i = 0; i < 2; ++i) { int ch = tid + i * 256; int row = ch >> 3, kc = ch & 7; rv[i] = *(const U4*)(Vp + (size_t)row * SEQ + k0 + kc * 8); }
      }
      f32x4 S[4][2];
#pragma unroll
      for (int i = 0; i < 4; ++i)
#pragma unroll
        for (int j = 0; j < 2; ++j) S[i][j] = f32x4{0.f, 0.f, 0.f, 0.f};
#pragma unroll
      for (int ks = 0; ks < 3; ++ks)
#pragma unroll
        for (int k4 = 0; k4 < 4; ++k4) {
          bf16x8 kf = *(const bf16x8*)(sK + (k4 * 16 + c) * KS + ks * 32 + g * 8);
          S[k4][0] = __builtin_amdgcn_mfma_f32_16x16x32_bf16(kf, qf[0][ks], S[k4][0], 0, 0, 0);
          S[k4][1] = __builtin_amdgcn_mfma_f32_16x16x32_bf16(kf, qf[1][ks], S[k4][1], 0, 0, 0);
        }
      bf16x8 pf[2][2];
#pragma unroll
      for (int qt = 0; qt < 2; ++qt) {
        float mx = S[0][qt][0];
#pragma unroll
        for (int k4 = 0; k4 < 4; ++k4)
#pragma unroll
          for (int r = 0; r < 4; ++r) mx = fmaxf(mx, S[k4][qt][r]);
        {
          const auto r16_ = __builtin_amdgcn_permlane16_swap(__float_as_uint(mx), __float_as_uint(mx), false, false);
          mx = fmaxf(__uint_as_float(r16_[0]), __uint_as_float(r16_[1]));
          const auto r32_ = __builtin_amdgcn_permlane32_swap(__float_as_uint(mx), __float_as_uint(mx), false, false);
          mx = fmaxf(__uint_as_float(r32_[0]), __uint_as_float(r32_[1]));
        }
        float mnew = mrun[qt];
        if (__any(mx > mrun[qt] + 6.f)) {
          mnew = fmaxf(mrun[qt], mx);
          const float alpha = __builtin_amdgcn_exp2f(mrun[qt] - mnew);
          mrun[qt] = mnew;
          lrun[qt] *= alpha;
#pragma unroll
          for (int dt = 0; dt < 4; ++dt)
#pragma unroll
            for (int r = 0; r < 4; ++r) O[dt][qt][r] *= alpha;
        }
        float ls = 0.f;
        float pv[16];
#pragma unroll
        for (int k4 = 0; k4 < 4; ++k4)
#pragma unroll
          for (int r = 0; r < 4; ++r) { float e = __builtin_amdgcn_exp2f(S[k4][qt][r] - mnew); pv[k4 * 4 + r] = e; ls += e; }
        lrun[qt] += ls;
#pragma unroll
        for (int kk = 0; kk < 2; ++kk) {
          typedef __attribute__((ext_vector_type(4))) unsigned u32x4;
          u32x4 w = {pack2(pv[kk * 8 + 0], pv[kk * 8 + 1]), pack2(pv[kk * 8 + 2], pv[kk * 8 + 3]),
                     pack2(pv[kk * 8 + 4], pv[kk * 8 + 5]), pack2(pv[kk * 8 + 6], pv[kk * 8 + 7])};
          pf[qt][kk] = __builtin_bit_cast(bf16x8, w);
        }
      }
#pragma unroll
      for (int kk = 0; kk < 2; ++kk)
#pragma unroll
        for (int dt = 0; dt < 4; ++dt) {
          typedef __attribute__((ext_vector_type(4))) unsigned u32x4;
          const u16* vp = sV + (dt * 16 + c) * VS + kk * 32 + g * 4;
          U2 lo = *(const U2*)vp, hi = *(const U2*)(vp + 16);
          u32x4 w = {lo.x, lo.y, hi.x, hi.y};
          bf16x8 vf = __builtin_bit_cast(bf16x8, w);
          O[dt][0] = __builtin_amdgcn_mfma_f32_16x16x32_bf16(vf, pf[0][kk], O[dt][0], 0, 0, 0);
          O[dt][1] = __builtin_amdgcn_mfma_f32_16x16x32_bf16(vf, pf[1][kk], O[dt][1], 0, 0, 0);
        }
    }
    const int b = bh >> 3, h = bh & 7;
#pragma unroll
    for (int qt = 0; qt < 2; ++qt) {
      float l = lrun[qt];
      l += __shfl_xor(l, 16); l += __shfl_xor(l, 32);
      const float inv = 1.f / l;
      const int s = qb * 128 + wave * 32 + qt * 16 + c;
      u16* dst = p.attn_out + ((size_t)(b * SEQ + s)) * 512 + h * 64;
#pragma unroll
      for (int dt = 0; dt < 4; ++dt) {
        U2 o; o.x = pack2(O[dt][qt][0] * inv, O[dt][qt][1] * inv); o.y = pack2(O[dt][qt][2] * inv, O[dt][qt][3] * inv);
        *(U2*)(dst + dt * 16 + g * 4) = o;
      }
    }
  }
  if (bid < (nb >> 1)) { for (int ch = bid; ch < 512; ch += nb) hyena_channel(p, smem, ch); }
}

__device__ __forceinline__ void phase4(const Params& p, unsigned char* smem, int bid, int nb) {
  const int tid = tidx(), lane = tid & 63, wave = __builtin_amdgcn_readfirstlane(tid >> 6);
  const int wm = wave >> 1, wn = wave & 1, c = lane & 15, g = lane >> 4;
  for (int it = bid; it < 1024; it += nb) {
    const int li_ = (it & 511) >> 3;
    const int m0 = (64 * (it >> 9) + 8 * (it & 7) + (li_ >> 3)) * 128, n0 = (li_ & 7) * 128;
    f32x4 acc[4][4];
#pragma unroll
    for (int i = 0; i < 4; ++i)
#pragma unroll
      for (int j = 0; j < 4; ++j) acc[i][j] = f32x4{0.f, 0.f, 0.f, 0.f};
    gemm_glds<128, 128, 2, 2, true>(p.attn_out, 512, p.w_oaT, 512, 512, m0, n0, smem, acc);
    const u16* gb = p.gates + (size_t)(m0 + wm * 64 + c) * 2048 + n0 + wn * 64 + g * 4;
#pragma unroll
    for (int mt = 0; mt < 4; ++mt)
#pragma unroll
      for (int nt = 0; nt < 4; ++nt) {
        const U2 ga = *(const U2*)(gb + (mt * 16) * 2048 + nt * 16);
        const U2 gh = *(const U2*)(gb + (mt * 16) * 2048 + nt * 16 + 1024);
        acc[mt][nt][0] *= bflo(ga.x) * __frcp_rn(bflo(gh.x));
        acc[mt][nt][1] *= bfhi(ga.x) * __frcp_rn(bfhi(gh.x));
        acc[mt][nt][2] *= bflo(ga.y) * __frcp_rn(bflo(gh.y));
        acc[mt][nt][3] *= bfhi(ga.y) * __frcp_rn(bfhi(gh.y));
      }
    gemm_glds_at<true>(p.yhT, T_TOK, p.w_ohT, 512, 512, m0, n0, smem, acc);
    u16* mb = p.merged + (size_t)(m0 + wm * 64 + c) * 1024 + n0 + wn * 64 + g * 4;
#pragma unroll
    for (int mt = 0; mt < 4; ++mt)
#pragma unroll
      for (int nt = 0; nt < 4; ++nt) {
        const U2 gh = *(const U2*)(gb + (mt * 16) * 2048 + nt * 16 + 1024);
        U2 o;
        o.x = pack2(acc[mt][nt][0] * bflo(gh.x), acc[mt][nt][1] * bfhi(gh.x));
        o.y = pack2(acc[mt][nt][2] * bflo(gh.y), acc[mt][nt][3] * bfhi(gh.y));
        *(U2*)(mb + (mt * 16) * 1024 + nt * 16) = o;
      }
  }
}

__device__ __forceinline__ void phase5(const Params& p, unsigned char* smem, int bid, int nb) {
  const int tid = tidx(), lane = tid & 63, wave = __builtin_amdgcn_readfirstlane(tid >> 6);
  const int wm = wave >> 1, wn = wave & 1, c = lane & 15, g = lane >> 4;
  for (int it = bid; it < 1024; it += nb) {
    const int li_ = (it & 511) >> 3;
    const int m0 = (64 * (it >> 9) + 8 * (it & 7) + (li_ >> 3)) * 128, n0 = (li_ & 7) * 128;
    f32x4 acc[4][4];
#pragma unroll
    for (int i = 0; i < 4; ++i)
#pragma unroll
      for (int j = 0; j < 4; ++j) acc[i][j] = f32x4{0.f, 0.f, 0.f, 0.f};
    gemm_glds<128, 128, 2, 2, true>(p.merged, 1024, p.w_outT, 1024, 1024, m0, n0, smem, acc);
#pragma unroll
    for (int mt = 0; mt < 4; ++mt) {
      const int t = m0 + wm * 64 + mt * 16 + c;
      float ss = 0.f;
#pragma unroll
      for (int nt = 0; nt < 4; ++nt) {
        const int n = n0 + wn * 64 + nt * 16 + g * 4;
        const F4 xv = *(const F4*)(p.x + (size_t)t * 1024 + n);
        const F4 gn = *(const F4*)(p.ffn_norm + n);
        F4 h1;
        h1.x = xv.x + acc[mt][nt][0]; h1.y = xv.y + acc[mt][nt][1]; h1.z = xv.z + acc[mt][nt][2]; h1.w = xv.w + acc[mt][nt][3];
        *(F4*)(p.out + (size_t)t * 1024 + n) = h1;
        U2 o; o.x = pack2(h1.x * gn.x, h1.y * gn.y); o.y = pack2(h1.z * gn.z, h1.w * gn.w);
        *(U2*)(p.hb + (size_t)t * 1024 + n) = o;
        ss += h1.x * h1.x + h1.y * h1.y + h1.z * h1.z + h1.w * h1.w;
      }
      ss += __shfl_xor(ss, 16); ss += __shfl_xor(ss, 32);
      if (g == 0) p.ssq2[t * 16 + (n0 >> 6) + wn] = ss;
    }
  }
}

#define KEY_INSERT(xk)                                                               \
  {                                                                                  \
    float x_ = (xk);                                                                 \
    _Pragma("unroll") for (int k_ = 0; k_ < 16; ++k_) {                              \
      const float hi_ = fmaxf(tv[k_], x_); x_ = fminf(tv[k_], x_); tv[k_] = hi_;    \
    }                                                                                \
  }

__device__ __forceinline__ void phase6(const Params& p, unsigned char* smem, int bid, int nb) {
  float* sc = (float*)smem;
  float* rsl = (float*)(smem + OFF_RS);
  const int tid = tidx(), lane = tid & 63, wave = __builtin_amdgcn_readfirstlane(tid >> 6), c = lane & 15, g = lane >> 4;
  const int wm = wave >> 1, wn = wave & 1;
  if (bid >= (nb >> 1)) { ph_expert_fp8(p.eu, p.eu8, p.eus, bid, nb); ph_expert_fp8(p.ev, p.ev8, p.evs, bid, nb); }
  for (int it = bid; it < 2048; it += nb) {
    const int li_ = (it & 511) >> 3;
    const int hs = li_ & 15, m0 = (32 * (it >> 9) + 4 * (it & 7) + (li_ >> 4)) * 128;
    __syncthreads();
    if (tid < 128) {
      const float* sq = p.ssq2 + (size_t)(m0 + tid) * 16;
      float s = 0.f;
#pragma unroll
      for (int i = 0; i < 16; ++i) s += sq[i];
      rsl[tid] = rsqrtf(s * (1.f / 1024.f) + EPS);
    }
    f32x4 acc[4][4];
#pragma unroll
    for (int i = 0; i < 4; ++i)
#pragma unroll
      for (int j = 0; j < 4; ++j) acc[i][j] = f32x4{0.f, 0.f, 0.f, 0.f};
    gemm_glds<128, 128, 2, 2>(p.hb, 1024, p.wcT, 1024, 1024, m0, hs * 128, smem, acc);
#pragma unroll
    for (int mt = 0; mt < 4; ++mt)
#pragma unroll
      for (int r = 0; r < 4; ++r) {
        const int rl = wm * 64 + mt * 16 + g * 4 + r;
        const float rstd = rsl[rl];
#pragma unroll
        for (int nt = 0; nt < 4; ++nt) {
          const int col = wn * 64 + nt * 16 + c;
          const unsigned kb = (__float_as_uint(acc[mt][nt][r] * rstd) & 0xffffff80u) | (unsigned)col;
          sc[rl * 129 + col] = __uint_as_float(kb);
        }
      }
    __syncthreads();
    float tv[16];
    const int row = tid & 127;
    float* seg = sc + row * 129 + (tid >> 7) * 64;
#pragma unroll
    for (int k = 0; k < 16; ++k) tv[k] = -3.0e38f;
#pragma unroll 8
    for (int j = 0; j < 64; ++j) { KEY_INSERT(seg[j]) }
    if (tid >= 128) {
#pragma unroll
      for (int k = 0; k < 16; ++k) seg[k] = tv[k];
    }
    __syncthreads();
    if (tid < 128) {
#pragma unroll
      for (int k = 0; k < 16; ++k) tv[k] = fmaxf(tv[k], seg[64 + 15 - k]);
#pragma unroll
      for (int st = 8; st > 0; st >>= 1)
#pragma unroll
        for (int k = 0; k < 16; ++k)
          if ((k & st) == 0) { const float hi = fmaxf(tv[k], tv[k + st]), lo = fminf(tv[k], tv[k + st]); tv[k] = hi; tv[k + st] = lo; }
      F4* dst = (F4*)(p.tk + ((size_t)(m0 + row) * 16 + hs) * 16);
      dst[0] = F4{tv[0], tv[1], tv[2], tv[3]}; dst[1] = F4{tv[4], tv[5], tv[6], tv[7]};
      dst[2] = F4{tv[8], tv[9], tv[10], tv[11]}; dst[3] = F4{tv[12], tv[13], tv[14], tv[15]};
    }
  }
  if (bid < (nb >> 1)) { ph_expert_fp8(p.eu, p.eu8, p.eus, bid, nb); ph_expert_fp8(p.ev, p.ev8, p.evs, bid, nb); }
}

__device__ __forceinline__ void combine_task(const Params& p, int task, int* oi, float* og) {
  const float* s1 = p.tk + (size_t)task * 32; const float* s2 = s1 + 16;
  float v1[16], v2[16];
#pragma unroll
  for (int k4 = 0; k4 < 4; ++k4) {
    const F4 a = ((const F4*)s1)[k4], b = ((const F4*)s2)[k4];
    v1[4 * k4] = a.x; v1[4 * k4 + 1] = a.y; v1[4 * k4 + 2] = a.z; v1[4 * k4 + 3] = a.w;
    v2[4 * k4] = b.x; v2[4 * k4 + 1] = b.y; v2[4 * k4 + 2] = b.z; v2[4 * k4 + 3] = b.w;
  }
  float tv[16];
#pragma unroll
  for (int k = 0; k < 16; ++k) tv[k] = -3.0e38f;
#pragma unroll
  for (int a = 0; a < 16; ++a)
#pragma unroll
    for (int b = 0; b < 16; ++b)
      if ((a + 1) * (b + 1) <= 16) {
        const unsigned kb = (__float_as_uint(v1[a] + v2[b]) & 0xffffff00u) | (unsigned)(a * 16 + b);
        KEY_INSERT(__uint_as_float(kb))
      }
  float es[16]; float sum = 0.f;
#pragma unroll
  for (int k = 0; k < 16; ++k) { es[k] = __expf(tv[k] - tv[0]); sum += es[k]; }
  const float inv = 1.f / sum;
#pragma unroll
  for (int k = 0; k < 16; ++k) {
    const unsigned ab = __float_as_uint(tv[k]) & 0xffu;
    const int a = ab >> 4, b = ab & 15;
    oi[k] = (int)(__float_as_uint(s1[a]) & 127u) * 128 + (int)(__float_as_uint(s2[b]) & 127u);
    og[k] = es[k] * inv;
  }
}
__device__ __forceinline__ void phase6b(const Params& p, int bid, int nb) {
  for (int task = bid * 256 + tidx(); task < T_TOK * 8; task += nb * 256)
    combine_task(p, task, p.sel_idx + (size_t)task * 16, p.sel_g + (size_t)task * 16);
}

__device__ __forceinline__ void unpack8(U4 v, float* f) {
  f[0] = bflo(v.x); f[1] = bfhi(v.x); f[2] = bflo(v.y); f[3] = bfhi(v.y);
  f[4] = bflo(v.z); f[5] = bfhi(v.z); f[6] = bflo(v.w); f[7] = bfhi(v.w);
}

__device__ __forceinline__ float dot16_fp8(U4 r, const float* hv) {
  f32x2 s2 = {0.f, 0.f};
#pragma unroll
  for (int k = 0; k < 4; ++k) {
    const f32x2 a = __builtin_amdgcn_cvt_pk_f32_fp8((int)r[k], false), b = __builtin_amdgcn_cvt_pk_f32_fp8((int)r[k], true);
    const f32x2 h0 = {hv[4 * k], hv[4 * k + 1]}, h1 = {hv[4 * k + 2], hv[4 * k + 3]};
    s2 = __builtin_elementwise_fma(a, h0, s2);
    s2 = __builtin_elementwise_fma(b, h1, s2);
  }
  return s2.x + s2.y;
}
__device__ __forceinline__ void axpy16_fp8(U4 r, float w, float* acc) {
  const f32x2 w2 = {w, w};
#pragma unroll
  for (int k = 0; k < 4; ++k) {
    const f32x2 a = __builtin_amdgcn_cvt_pk_f32_fp8((int)r[k], false), b = __builtin_amdgcn_cvt_pk_f32_fp8((int)r[k], true);
    f32x2 c0 = {acc[4 * k], acc[4 * k + 1]}, c1 = {acc[4 * k + 2], acc[4 * k + 3]};
    c0 = __builtin_elementwise_fma(w2, a, c0);
    c1 = __builtin_elementwise_fma(w2, b, c1);
    acc[4 * k] = c0.x; acc[4 * k + 1] = c0.y; acc[4 * k + 2] = c1.x; acc[4 * k + 3] = c1.y;
  }
}
#define P7_LOAD(dst, tab, bidx)                                                               \
  _Pragma("unroll") for (int j_ = 0; j_ < 8; ++j_) {                                          \
    const int e_ = (bidx) * 8 + j_;                                                           \
    const int id_ = __builtin_amdgcn_readlane((e_ < 64) ? id0 : id1, e_ & 63);                \
    dst[j_] = *(const U4*)((tab) + (size_t)id_ * 1024 + lane * 16);                           \
  }
__device__ __forceinline__ float swapsum32(float a, float b) {
  const auto r = __builtin_amdgcn_permlane32_swap(__float_as_uint(a), __float_as_uint(b), false, false);
  return __uint_as_float(r[0]) + __uint_as_float(r[1]);
}
__device__ __forceinline__ float swapsum16(float a, float b) {
  const auto r = __builtin_amdgcn_permlane16_swap(__float_as_uint(a), __float_as_uint(b), false, false);
  return __uint_as_float(r[0]) + __uint_as_float(r[1]);
}
template <int CTRL>
__device__ __forceinline__ float dppf(float v) { return __int_as_float(__builtin_amdgcn_update_dpp(0, __float_as_int(v), CTRL, 0xF, 0xF, true)); }
#define P7_ACT(src, bidx)                                                                     \
  {                                                                                           \
    float d_[8];                                                                              \
    _Pragma("unroll") for (int j_ = 0; j_ < 8; ++j_) d_[j_] = dot16_fp8(src[j_], hv);         \
    const float r10_ = swapsum32(d_[0], d_[1]), r11_ = swapsum32(d_[2], d_[3]);               \
    const float r12_ = swapsum32(d_[4], d_[5]), r13_ = swapsum32(d_[6], d_[7]);               \
    const float r20_ = swapsum16(r10_, r11_), r21_ = swapsum16(r12_, r13_);                   \
    const float keep_ = (lane & 8) ? r21_ : r20_;                                             \
    const float send_ = (lane & 8) ? r20_ : r21_;                                             \
    float r3_ = keep_ + dppf<0x128>(send_);                   \
    r3_ += dppf<0x141>(r3_);                                  \
    r3_ += dppf<0xB1>(r3_);                                            \
    r3_ += dppf<0x4E>(r3_);                                            \
    if ((lane & 7) == 0) wl[(bidx) * 8 + jl] = r3_;                                           \
  }
#define P7_ACC(src, bidx)                                                                     \
  {                                                                                           \
    const F4 wa_ = *(const F4*)(wl + (bidx) * 8), wb_ = *(const F4*)(wl + (bidx) * 8 + 4);    \
    axpy16_fp8(src[0], wa_.x, acc); axpy16_fp8(src[1], wa_.y, acc);                           \
    axpy16_fp8(src[2], wa_.z, acc); axpy16_fp8(src[3], wa_.w, acc);                           \
    axpy16_fp8(src[4], wb_.x, acc); axpy16_fp8(src[5], wb_.y, acc);                           \
    axpy16_fp8(src[6], wb_.z, acc); axpy16_fp8(src[7], wb_.w, acc);                           \
  }

__device__ __forceinline__ void sort128(int& r0, int& r1, int lane) {
#pragma unroll
  for (int k = 2; k <= 128; k <<= 1) {
#pragma unroll
    for (int j = k >> 1; j > 0; j >>= 1) {
      if (j == 64) { const int lo = min(r0, r1), hi = max(r0, r1); r0 = lo; r1 = hi; }
      else {
        const bool lower = (lane & j) == 0;
        { const int pv = __shfl_xor(r0, j); const bool asc = (k == 128) || ((lane & k) == 0); r0 = (lower == asc) ? min(r0, pv) : max(r0, pv); }
        { const int pv = __shfl_xor(r1, j); const bool asc = (k == 128) || (((64 + lane) & k) == 0); r1 = (lower == asc) ? min(r1, pv) : max(r1, pv); }
      }
    }
  }
}

__device__ __forceinline__ void phase7(const Params& p, unsigned char* smem, int bid, int nb, float* outp, bool fused) {
  const int tid = tidx(), lane = tid & 63, wave = __builtin_amdgcn_readfirstlane(tid >> 6);
  float* wl0 = (float*)smem + wave * 2048;
  int* sidl0 = (int*)smem + 8192 + wave * 2048;
  const int jl = ((lane >> 3) & 1) * 4 + ((lane >> 4) & 1) * 2 + ((lane >> 5) & 1);
  const int tstep = nb * 4;
  int* selI = sidl0 + 1024; float* selG = wl0 + 1024;
  if (fused) {
    const int t = bid * 4 + wave + (lane >> 3) * tstep;
    if (t < T_TOK) combine_task(p, t * 8 + (lane & 7), selI + lane * 16, selG + lane * 16);
  }
  {
    int k = 0;
#pragma unroll 1
    for (int t = bid * 4 + wave; t < T_TOK; t += tstep, ++k) {
      float* wl = wl0 + k * 128;
      const U4* hr = (const U4*)(p.hb + (size_t)t * 1024 + lane * 16);
      float hv[16];
      unpack8(hr[0], hv); unpack8(hr[1], hv + 8);
      float s = 0.f;
#pragma unroll
      for (int i = 0; i < 16; ++i) s += p.ssq2[(size_t)t * 16 + i];
      const float rstd = rsqrtf(s * (1.f / 1024.f) + EPS);
      int k0 = ((fused ? selI[k * 128 + lane] : p.sel_idx[(size_t)t * 128 + lane]) << 7) | lane;
      int k1 = ((fused ? selI[k * 128 + 64 + lane] : p.sel_idx[(size_t)t * 128 + 64 + lane]) << 7) | (64 + lane);
      sort128(k0, k1, lane);
      const int id0 = k0 >> 7, id1 = k1 >> 7;
      sidl0[k * 128 + lane] = id0; sidl0[k * 128 + 64 + lane] = id1;
      const float us0 = p.eus[id0] * rstd, us1 = p.eus[id1] * rstd;
      const float gv0 = (fused ? selG[k * 128 + (k0 & 127)] : p.sel_g[(size_t)t * 128 + (k0 & 127)]) * p.evs[id0];
      const float gv1 = (fused ? selG[k * 128 + (k1 & 127)] : p.sel_g[(size_t)t * 128 + (k1 & 127)]) * p.evs[id1];
      U4 ba[8], bb[8], bc[8];
      P7_LOAD(ba, p.eu8, 0)
      P7_LOAD(bb, p.eu8, 1)
#pragma unroll 1
      for (int b = 0; b < 15; b += 3) {
        const int b3 = (b + 3 < 15) ? b + 3 : 15, b4 = (b + 4 < 15) ? b + 4 : 15;
        P7_LOAD(bc, p.eu8, b + 2)
        P7_ACT(ba, b)
        P7_LOAD(ba, p.eu8, b3)
        P7_ACT(bb, b + 1)
        P7_LOAD(bb, p.eu8, b4)
        P7_ACT(bc, b + 2)
      }
      P7_ACT(ba, 15)
      {
        const float x0 = wl[lane] * us0, x1 = wl[64 + lane] * us1;
        wl[lane] = gv0 * 0.5f * x0 * (1.f + erff(x0 * 0.70710678118654752f));
        wl[64 + lane] = gv1 * 0.5f * x1 * (1.f + erff(x1 * 0.70710678118654752f));
      }
    }
  }
#define P7B_LOAD(dst, bidx)                                                                    \
  _Pragma("unroll") for (int j_ = 0; j_ < 32; ++j_) {                                          \
    const int e_ = (bidx) * 32 + j_;                                                           \
    const int id_ = __builtin_amdgcn_readlane(((bidx) < 2) ? id0 : id1, e_ & 63);              \
    dst[j_] = *(const unsigned*)(vb + (size_t)id_ * 1024);                                     \
  }
#define P7B_ACC(src, bidx)                                                                     \
  _Pragma("unroll") for (int j4_ = 0; j4_ < 8; ++j4_) {                                        \
    const F4 w4_ = *(const F4*)(wl + (bidx) * 32 + j4_ * 4);                                   \
    _Pragma("unroll") for (int jj_ = 0; jj_ < 4; ++jj_) {                                      \
      const float ws_ = w4_[jj_];                                                              \
      const f32x2 w2_ = {ws_, ws_};                                                            \
      const int r_ = (int)src[j4_ * 4 + jj_];                                                  \
      a01 = __builtin_elementwise_fma(w2_, __builtin_amdgcn_cvt_pk_f32_fp8(r_, false), a01);   \
      a23 = __builtin_elementwise_fma(w2_, __builtin_amdgcn_cvt_pk_f32_fp8(r_, true), a23);    \
    }                                                                                          \
  }
#pragma unroll 1
  for (int q = 0; q < 4; ++q) {
    const unsigned char* vb = p.ev8 + q * 256 + lane * 4;
    int k = 0;
#pragma unroll 1
    for (int t = bid * 4 + wave; t < T_TOK; t += tstep, ++k) {
      const float* wl = wl0 + k * 128;
      const int id0 = sidl0[k * 128 + lane], id1 = sidl0[k * 128 + 64 + lane];
      unsigned ra[32], rb[32], rc[32];
      f32x2 a01 = {0.f, 0.f}, a23 = {0.f, 0.f};
      P7B_LOAD(ra, 0)
      P7B_LOAD(rb, 1)
      P7B_LOAD(rc, 2)
      P7B_ACC(ra, 0)
      P7B_LOAD(ra, 3)
      P7B_ACC(rb, 1)
      P7B_ACC(rc, 2)
      P7B_ACC(ra, 3)
      F4* o = (F4*)(outp + (size_t)t * 1024 + q * 256 + lane * 4);
      F4 v = *o;
      v.x += a01.x; v.y += a01.y; v.z += a23.x; v.w += a23.y;
      *o = v;
    }
  }
#undef P7B_LOAD
#undef P7B_ACC
}

__device__ __forceinline__ void run_phase(int ph, const Params& p, unsigned char* smem, int bid, int nb) {
#ifdef ONLY_PHASE
  if (ph != ONLY_PHASE) return;
#endif
  switch (ph) {
    case 0: phase0(p, smem, lbid(), nb); break;
    case 1: phase1<0>(p, smem, lbid(), nb); break;
    case 2: phase1<1>(p, smem, lbid(), nb); break;
    case 3: phase3(p, smem, lbid(), nb); break;
    case 4: phase4(p, smem, lbid(), nb); break;
    case 5: phase5(p, smem, lbid(), nb); break;
    case 6: phase6(p, smem, lbid(), nb); break;
    default: phase7(p, smem, lbid(), nb, p.out, false); break;
  }
}

__global__ void __launch_bounds__(256, 2) mega_kernel(Params p) {
  __shared__ __attribute__((aligned(16))) unsigned char smem[SMEM_BYTES];
  __shared__ U4 xb_words;
  cg::grid_group grid = cg::this_grid();
  const int bid = blockIdx.x, nb = gridDim.x;
  if (tidx() == 0) xb_words = U4{0u, 0u, 0u, 0u};
  __syncthreads();
  (void)xcd_barrier_post(p.bar, (volatile LAS unsigned*)&xb_words);
#define XBAR() do { XcdBarrier xb_; xb_.bar = p.bar; xb_.x = xb_xcc_id(); xb_.st = (volatile LAS unsigned*)&xb_words; xcd_barrier(xb_); } while (0)
#ifdef ONLY_PHASE
  run_phase(ONLY_PHASE, p, smem, bid, nb);
  grid.sync();
  XBAR();
#else
#ifndef DUP_PHASE
#define DUP_PHASE -1
#endif
#define DUP(k, call) if (DUP_PHASE == k) { call; XBAR(); }
  phase0(p, smem, lbid(), nb);
  if (p.use_cg) grid.sync();
  XBAR();
  DUP(0, phase0(p, smem, lbid(), nb))
  phase1<0>(p, smem, lbid(), nb); XBAR();
  DUP(1, phase1<1>(p, smem, lbid(), nb))
  phase1<1>(p, smem, lbid(), nb); XBAR();
  DUP(3, phase3(p, smem, lbid(), nb))
  phase3(p, smem, lbid(), nb); XBAR();
  DUP(4, phase4(p, smem, lbid(), nb))
  phase4(p, smem, lbid(), nb); XBAR();
  DUP(5, phase5(p, smem, lbid(), nb))
  phase5(p, smem, lbid(), nb); XBAR();
  DUP(6, phase6(p, smem, lbid(), nb))
  phase6(p, smem, lbid(), nb); XBAR();
  const bool fuse6b = (nb * 32 >= T_TOK);
  if (!fuse6b) { phase6b(p, lbid(), nb); XBAR(); }
  DUP(7, phase7(p, smem, lbid(), nb, (float*)p.K, fuse6b))
  phase7(p, smem, lbid(), nb, p.out, fuse6b);
#endif
}

#if MULTI_LAUNCH
__global__ void __launch_bounds__(256, 2) phase_kernel(Params p, int ph) {
  __shared__ __attribute__((aligned(16))) unsigned char smem[SMEM_BYTES];
  run_phase(ph, p, smem, blockIdx.x, gridDim.x);
}
#endif

extern "C" void kernel_launch(void* const* d_in, const int* in_sizes, int n_in, void* d_out, int out_size, void* d_ws,
                              size_t ws_size, hipStream_t stream) {
  (void)in_sizes; (void)n_in; (void)out_size;
  Params p{};
  const float** fp = (const float**)&p;
  for (int i = 0; i < 31; ++i) fp[i] = (const float*)d_in[i];
  p.out = (float*)d_out;
  unsigned char* w = (unsigned char*)d_ws;
  const size_t MB = 1024 * 1024;
  size_t off = 0;
  unsigned char* R1 = w + off; off += 64 * MB;
  unsigned char* R2 = w + off; off += 48 * MB;
  unsigned char* R3 = w + off; off += 32 * MB;
  unsigned char* R4 = w + off; off += 24 * MB;
  unsigned char* R5 = w + off; off += 16 * MB;
  unsigned char* R6 = w + off; off += 16 * MB;
  unsigned char* R7 = w + off; off += 24 * MB;
  auto take = [&](size_t bytes) { unsigned char* q = w + off; off += (bytes + 255) & ~(size_t)255; return q; };
  p.gates = (u16*)R1; p.eub = (u16*)R1; p.evb = (u16*)(R1 + 32 * MB); p.eu8 = R1; p.ev8 = R1 + 16 * MB;
  p.uT = (u16*)R2; p.merged = (u16*)R4; p.sel_idx = (int*)(R2 + 32 * MB); p.sel_g = (float*)(R2 + 40 * MB);
  p.xb = (u16*)R3; p.Q = (u16*)R7; p.hb = (u16*)R3;
  p.K = (u16*)R4; p.Vt = (u16*)R5;
  p.cq = (u16*)R6; p.ckv = (u16*)(R6 + 8 * MB); p.attn_out = (u16*)R6; p.tk = (float*)R6;
  p.yhT = (u16*)R3;
  p.w_inT = (u16*)take((size_t)4096 * 1024 * 2);
  p.w_uqT = (u16*)take((size_t)768 * 256 * 2);
  p.w_ukvT = (u16*)take((size_t)1024 * 128 * 2);
  p.w_oaT = (u16*)take((size_t)1024 * 512 * 2);
  p.w_ohT = (u16*)take((size_t)1024 * 512 * 2);
  p.w_outT = (u16*)take((size_t)1024 * 1024 * 2);
  p.wqb = (u16*)take((size_t)1024 * 2048 * 2);
  p.keysb = (u16*)take((size_t)2 * 8 * 128 * 128 * 2);
  p.wcT = (u16*)take((size_t)2048 * 1024 * 2);
  p.h3 = (float*)take((size_t)2048 * 64 * 4);
  p.rstd1 = (float*)take((size_t)T_TOK * 4);
  p.ssq2 = (float*)take((size_t)T_TOK * 16 * 4);
  p.bar = (unsigned*)take((size_t)XCD_BAR_WORDS * 4);
  p.eus = (float*)take((size_t)16384 * 4);
  p.filt = (u16*)take((size_t)1024 * 2048 * 2);
  p.use_cg = 0; p.pad_ = 0;
  p.evs = (float*)take((size_t)16384 * 4);
  if (off > ws_size) { fprintf(stderr, "workspace too small: need %zu have %zu\n", off, ws_size); return; }

  (void)hipMemsetAsync(p.bar, 0, (size_t)XCD_BAR_WORDS * 4, stream);
#if MULTI_LAUNCH
  for (int ph = 0; ph < 8; ++ph) phase_kernel<<<dim3(512), dim3(256), 0, stream>>>(p, ph);
#else
  static int grid_blocks = 0;
  if (!grid_blocks) {
    int dev = 0, cus = 0, per_cu = 0;
    (void)hipGetDevice(&dev);
    (void)hipDeviceGetAttribute(&cus, hipDeviceAttributeMultiprocessorCount, dev);
    (void)hipOccupancyMaxActiveBlocksPerMultiprocessor(&per_cu, mega_kernel, 256, 0);
    if (per_cu > 2) per_cu = 2;
    if (per_cu < 1) per_cu = 1;
    grid_blocks = cus * per_cu;
  }
  void* args[] = {&p};
  hipError_t e = hipLaunchCooperativeKernel((void*)mega_kernel, dim3(grid_blocks), dim3(256), args, 0, stream);
  if (e != hipSuccess) fprintf(stderr, "cooperative launch failed: %s (grid %d)\n", hipGetErrorString(e), grid_blocks);
#endif
}
```
